# Optimizing an MI355X kernel written in HIP

```python
import jax, jax.numpy as jnp
from jax import lax
import numpy as np

D_MODEL = 1024
BATCH = 4
SEQ = 8192
DEPTH = 2

CHUNK = 64
HEAD_DIM = 64
ROT_DIM = HEAD_DIM // 4
ROPE_THETA = 500000.0
N_HEADS_A = 6
N_HEADS_B = 5
N_HEADS_C = 5
WIDTH_A = N_HEADS_A * HEAD_DIM
WIDTH_B = N_HEADS_B * HEAD_DIM
WIDTH_C = N_HEADS_C * HEAD_DIM
MIX_WIDTH = WIDTH_A + WIDTH_B + WIDTH_C
IDX_HEADS = 8
IDX_DIM = 64
TOPK_MAX = 256
PREV_CHUNKS = 8
BAND = (PREV_CHUNKS + 1) * CHUNK
REL_CLIP = 128
Q_BLOCK = 128
N_BRANCH = 3
FFN_HIDDEN = -(-8 * D_MODEL // (3 * 256)) * 256
RMS_EPS = 1e-6
FORGET_BIAS_LO = 2.0
FORGET_BIAS_HI = 6.0
SPLIT_SIZES = (WIDTH_A, WIDTH_A, WIDTH_A, IDX_HEADS * IDX_DIM, IDX_DIM, IDX_HEADS,
               3 * WIDTH_B, 3 * WIDTH_C, N_HEADS_C, N_BRANCH * D_MODEL)
IN_WIDTH = sum(SPLIT_SIZES)

kernel_name = 'hybrid_gated_streaming_encoder'


def rmsnorm(x, g):
    xf = x.astype(jnp.float32)
    y = xf * lax.rsqrt(jnp.mean(xf * xf, axis=-1, keepdims=True) + RMS_EPS)
    return (y * g.astype(jnp.float32)).astype(x.dtype)


def rope_tables(positions):
    inv = ROPE_THETA ** (-jnp.arange(0, ROT_DIM, 2, dtype=jnp.float32) / ROT_DIM)
    ang = positions.astype(jnp.float32)[..., None] * inv
    return jnp.cos(ang), jnp.sin(ang)


def partial_rope(t, cos, sin):
    half = ROT_DIM // 2
    cs = cos[:, :, None, :].astype(t.dtype)
    sn = sin[:, :, None, :].astype(t.dtype)
    x1 = t[..., :half]
    x2 = t[..., half:ROT_DIM]
    return jnp.concatenate([x1 * cs - x2 * sn, x2 * cs + x1 * sn, t[..., ROT_DIM:]], axis=-1)


def dsa_attention(q, k, v, q_idx, k_idx, w_idx):
    B, S = q.shape[0], q.shape[1]
    topk = min(TOPK_MAX, S // 4)
    n_blk = S // Q_BLOCK
    key_chunk = jnp.arange(S) // CHUNK
    scale = HEAD_DIM ** -0.5
    kf = k_idx.astype(jnp.float32)
    gather = jax.vmap(lambda arr, ix: arr[ix])

    def block(i):
        start = i * Q_BLOCK
        qs = lax.dynamic_slice_in_dim(q, start, Q_BLOCK, axis=1)
        qis = lax.dynamic_slice_in_dim(q_idx, start, Q_BLOCK, axis=1).astype(jnp.float32)
        ws = lax.dynamic_slice_in_dim(w_idx, start, Q_BLOCK, axis=1).astype(jnp.float32)
        q_chunk = (start + jnp.arange(Q_BLOCK)) // CHUNK
        idx_scores = jnp.einsum('bqhs,bqh->bqs',
                                jax.nn.relu(jnp.einsum('bqhd,bsd->bqhs', qis, kf)), ws)
        adm = key_chunk[None, :] <= q_chunk[:, None]
        idx_scores = jnp.where(adm[None], idx_scores, -jnp.inf)
        _, sel = lax.top_k(idx_scores, topk)
        valid = (sel // CHUNK) <= q_chunk[None, :, None]
        k_sel = gather(k, sel)
        v_sel = gather(v, sel)
        logits = jnp.einsum('bqhd,bqkhd->bhqk', qs, k_sel).astype(jnp.float32) * scale
        logits = jnp.where(valid[:, None], logits, -jnp.inf)
        p = jax.nn.softmax(logits, axis=-1).astype(v.dtype)
        return jnp.einsum('bhqk,bqkhd->bqhd', p, v_sel)

    out = lax.map(block, jnp.arange(n_blk))
    return jnp.moveaxis(out, 0, 1).reshape(B, S, -1)


def chunk_band_attention(q, k, v, rel_bias):
    B, S, H, Dh = q.shape
    n_c = S // CHUNK
    pad = PREV_CHUNKS * CHUNK
    qc = q.reshape(B, n_c, CHUNK, H, Dh)
    kp = jnp.pad(k, ((0, 0), (pad, 0), (0, 0), (0, 0))).reshape(B, n_c + PREV_CHUNKS, CHUNK, H, Dh)
    vp = jnp.pad(v, ((0, 0), (pad, 0), (0, 0), (0, 0))).reshape(B, n_c + PREV_CHUNKS, CHUNK, H, Dh)
    kband = jnp.concatenate([kp[:, j:j + n_c] for j in range(PREV_CHUNKS + 1)], axis=2)
    vband = jnp.concatenate([vp[:, j:j + n_c] for j in range(PREV_CHUNKS + 1)], axis=2)
    logits = jnp.einsum('bcqhd,bckhd->bchqk', qc, kband).astype(jnp.float32) * (Dh ** -0.5)
    qi = jnp.arange(CHUNK)
    kj = jnp.arange(BAND)
    dist = jnp.clip(qi[:, None] + pad - kj[None, :], -REL_CLIP, REL_CLIP) + REL_CLIP
    bias = rel_bias[:, dist].astype(jnp.float32)
    band_chunk = jnp.arange(n_c)[:, None] - PREV_CHUNKS + kj[None, :] // CHUNK
    valid = band_chunk >= 0
    logits = jnp.where(valid[None, :, None, None, :], logits + bias[None, None], -jnp.inf)
    p = jax.nn.softmax(logits, axis=-1).astype(v.dtype)
    out = jnp.einsum('bchqk,bckhd->bcqhd', p, vband)
    return out.reshape(B, S, H * Dh)


def forgetting_attention(q, k, v, f_logit):
    B, S, H, Dh = q.shape
    n_blk = S // Q_BLOCK
    log_f = jax.nn.log_sigmoid(f_logit.astype(jnp.float32))
    F = jnp.moveaxis(jnp.cumsum(log_f, axis=1), 1, 2)
    key_pos = jnp.arange(S)
    scale = Dh ** -0.5

    def block(i):
        start = i * Q_BLOCK
        qs = lax.dynamic_slice_in_dim(q, start, Q_BLOCK, axis=1)
        Fq = lax.dynamic_slice_in_dim(F, start, Q_BLOCK, axis=2)
        logits = (jnp.einsum('bqhd,bshd->bhqs', qs, k).astype(jnp.float32) * scale
                  + Fq[..., :, None] - F[:, :, None, :])
        qpos = start + jnp.arange(Q_BLOCK)
        logits = jnp.where((key_pos[None, :] <= qpos[:, None])[None, None], logits, -jnp.inf)
        p = jax.nn.softmax(logits, axis=-1).astype(v.dtype)
        return jnp.einsum('bhqs,bshd->bqhd', p, v)

    out = lax.map(block, jnp.arange(n_blk))
    return jnp.moveaxis(out, 0, 1).reshape(B, S, H * Dh)


def hybrid_mixer(h, cos, sin, w_in, b_in, rel_bias, w_branch, w_out):
    B, S, D = h.shape
    proj = h @ w_in + b_in
    parts = []
    off = 0
    for size in SPLIT_SIZES:
        parts.append(proj[..., off:off + size])
        off += size
    qa, ka, va, qi, ki, wi, qkv_b, qkv_c, f_c, gate_logits = parts
    qa = partial_rope(qa.reshape(B, S, N_HEADS_A, HEAD_DIM), cos, sin)
    ka = partial_rope(ka.reshape(B, S, N_HEADS_A, HEAD_DIM), cos, sin)
    va = va.reshape(B, S, N_HEADS_A, HEAD_DIM)
    qi = partial_rope(qi.reshape(B, S, IDX_HEADS, IDX_DIM), cos, sin)
    ki = partial_rope(ki[:, :, None, :], cos, sin)[:, :, 0, :]
    wi = wi * (IDX_HEADS ** -0.5 * IDX_DIM ** -0.5)
    o_a = dsa_attention(qa, ka, va, qi, ki, wi)
    qkv_b = qkv_b.reshape(B, S, 3, N_HEADS_B, HEAD_DIM)
    o_b = chunk_band_attention(qkv_b[:, :, 0], qkv_b[:, :, 1], qkv_b[:, :, 2], rel_bias)
    qkv_c = qkv_c.reshape(B, S, 3, N_HEADS_C, HEAD_DIM)
    o_c = forgetting_attention(qkv_c[:, :, 0], qkv_c[:, :, 1], qkv_c[:, :, 2], f_c)
    gates = jax.nn.sigmoid(gate_logits.reshape(B, S, N_BRANCH, D))
    y = (gates[:, :, 0] * (o_a @ w_branch[:WIDTH_A])
         + gates[:, :, 1] * (o_b @ w_branch[WIDTH_A:WIDTH_A + WIDTH_B])
         + gates[:, :, 2] * (o_c @ w_branch[WIDTH_A + WIDTH_B:]))
    return y @ w_out


def swiglu(h, w_ffn_in, w_ffn_out):
    gu = h @ w_ffn_in
    g, u = gu[..., :FFN_HIDDEN], gu[..., FFN_HIDDEN:]
    return (jax.nn.silu(g) * u) @ w_ffn_out


def setup_inputs(seed: int = 0) -> dict:
    key = jax.random.key(seed)
    ks = jax.random.split(key, 16)
    f32 = jnp.float32
    D = D_MODEL
    nrm = jax.random.normal
    x = nrm(ks[0], (BATCH, SEQ, D), f32)
    c = nrm(ks[1], (BATCH, D), f32)
    offset = jax.random.randint(ks[2], (BATCH, 1), 0, 4096, dtype=jnp.int32)
    positions = offset + jnp.arange(SEQ, dtype=jnp.int32)[None, :]
    ada_w = 0.5 * D ** -0.5 * nrm(ks[3], (DEPTH, D, 6 * D), f32)
    ada_b = 0.01 * nrm(ks[4], (DEPTH, 6 * D), f32)
    norm1_g = 1.0 + 0.05 * nrm(ks[5], (DEPTH, D), f32)
    w_in = D ** -0.5 * nrm(ks[6], (DEPTH, D, IN_WIDTH), f32)
    f_off = sum(SPLIT_SIZES[:8])
    forget_b = jax.random.uniform(ks[7], (DEPTH, N_HEADS_C), f32, FORGET_BIAS_LO, FORGET_BIAS_HI)
    b_in = (0.01 * nrm(ks[8], (DEPTH, IN_WIDTH), f32)).at[:, f_off:f_off + N_HEADS_C].add(forget_b)
    rel_bias = 0.5 * nrm(ks[9], (DEPTH, N_HEADS_B, 2 * REL_CLIP + 1), f32)
    w_branch = WIDTH_B ** -0.5 * nrm(ks[10], (DEPTH, MIX_WIDTH, D), f32)
    w_out = D ** -0.5 * nrm(ks[11], (DEPTH, D, D), f32)
    norm2_g = 1.0 + 0.05 * nrm(ks[12], (DEPTH, D), f32)
    w_ffn_in = D ** -0.5 * nrm(ks[13], (DEPTH, D, 2 * FFN_HIDDEN), f32)
    w_ffn_out = FFN_HIDDEN ** -0.5 * nrm(ks[14], (DEPTH, FFN_HIDDEN, D), f32)
    final_g = 1.0 + 0.05 * nrm(ks[15], (D,), f32)
    return {'x': x, 'c': c, 'positions': positions, 'ada_w': ada_w, 'ada_b': ada_b,
            'norm1_g': norm1_g, 'w_in': w_in, 'b_in': b_in, 'rel_bias': rel_bias,
            'w_branch': w_branch, 'w_out': w_out, 'norm2_g': norm2_g,
            'w_ffn_in': w_ffn_in, 'w_ffn_out': w_ffn_out, 'final_g': final_g}


def reference(x, c, positions, ada_w, ada_b, norm1_g, w_in, b_in, rel_bias,
              w_branch, w_out, norm2_g, w_ffn_in, w_ffn_out, final_g):
    cos, sin = rope_tables(positions)
    cond = jax.nn.silu(c)
    for l in range(DEPTH):
        mod = (cond @ ada_w[l] + ada_b[l])[:, None, :]
        sh1, sc1, g1, sh2, sc2, g2 = jnp.split(mod, 6, axis=-1)
        h = rmsnorm(x, norm1_g[l]) * (1 + sc1) + sh1
        x = x + g1 * hybrid_mixer(h, cos, sin, w_in[l], b_in[l], rel_bias[l], w_branch[l], w_out[l])
        h = rmsnorm(x, norm2_g[l]) * (1 + sc2) + sh2
        x = x + g2 * swiglu(h, w_ffn_in[l], w_ffn_out[l])
    return rmsnorm(x, final_g)
```

```cpp
#include <hip/hip_runtime.h>
#include <cstdio>
#include <cstdint>
#include <cmath>

#define GAS __attribute__((address_space(1)))
#define LAS __attribute__((address_space(3)))
#define CAS __attribute__((address_space(4)))
typedef unsigned short bf16_t;
typedef short bf16x8 __attribute__((ext_vector_type(8)));
typedef short s16x4 __attribute__((ext_vector_type(4)));
typedef float f32x4 __attribute__((ext_vector_type(4)));
typedef float f32x2 __attribute__((ext_vector_type(2)));
typedef float f32x16 __attribute__((ext_vector_type(16)));
typedef unsigned u32x4 __attribute__((ext_vector_type(4)));
typedef unsigned u32x2 __attribute__((ext_vector_type(2)));
typedef unsigned long long u64;

constexpr int NB = 4, SEQ = 8192, DM = 1024, MTOK = NB * SEQ, DEPTH = 2;
constexpr int IN_W = 6733, FFH = 2816, NP1 = 3840, NP2 = 3072, KBR = 384, MIXW = 3 * KBR;
constexpr int SRC_QA = 0, SRC_KA = 384, SRC_VA = 768, SRC_QI = 1152, SRC_KI = 1664, SRC_WI = 1728, SRC_B = 1736, SRC_C = 2696, SRC_F = 3656, SRC_G = 3661;
constexpr float LOG2E = 1.4426950408889634f;
constexpr float QSCALE = 0.125f * LOG2E;
constexpr float WI_SCALE = 0.5f * 0.35355339059327373f * 0.125f;
constexpr float RMS_EPS = 1e-6f;

constexpr size_t MiB = 1u << 20;
constexpr size_t WS_CTL = 0, CTL_ZERO_BYTES = 1 * MiB;
constexpr size_t WS_MOD = 1 * MiB;
constexpr size_t WS_BP1 = WS_MOD + 256 * 1024;
constexpr size_t WS_BP2 = WS_BP1 + 64 * 1024;
constexpr size_t WS_COS = 2 * MiB, WS_SIN = 3 * MiB;
constexpr size_t WS_WI = 4 * MiB, WS_FC = 5 * MiB;
constexpr size_t WS_FCUM = 6 * MiB;
constexpr size_t WS_SMAX = WS_FCUM + 768 * 1024;
constexpr size_t WS_SSF = 6 * MiB + 832 * 1024;
constexpr size_t WS_SS = 7 * MiB;
constexpr size_t WS_CB = WS_SS + 512 * 1024;
constexpr int NCB1 = NP1 + NP2, NCB2 = 2 * FFH;
constexpr size_t CB2_OFF = (size_t)DEPTH * 4 * NCB1;
static_assert(WS_CB + (CB2_OFF + (size_t)DEPTH * 4 * NCB2) * 4 <= 8 * MiB, "cb");
constexpr size_t WS_W = 8 * MiB, W_LAYER = 40 * MiB;
constexpr size_t W_P1 = 0, W_P2 = W_P1 + (size_t)NP1 * DM * 2, W_BR = W_P2 + (size_t)NP2 * DM * 2, W_OUT = W_BR + (size_t)3072 * KBR * 2,
                 W_F1 = W_OUT + (size_t)DM * 3072 * 2, W_F2 = W_F1 + (size_t)2 * FFH * DM * 2, W_END = W_F2 + (size_t)DM * FFH * 2;
static_assert(W_END <= W_LAYER, "weights");
constexpr size_t WS_H = 88 * MiB;
constexpr size_t WS_P = 152 * MiB;
constexpr size_t P_QA = WS_P, P_KA = P_QA + 24 * MiB, P_VA = P_KA + 24 * MiB, P_QI = P_VA + 24 * MiB, P_KI = P_QI + 32 * MiB,
                 P_QB = P_KI + 4 * MiB, P_KB = P_QB + 20 * MiB, P_VB = P_KB + 20 * MiB, P_QC = P_VB + 20 * MiB, P_KC = P_QC + 20 * MiB, P_VC = P_KC + 20 * MiB, P_END = P_VC + 20 * MiB;
constexpr size_t WS_Y = 344 * MiB;
constexpr size_t WS_BM = 384 * MiB;
constexpr size_t WS_MIX = 416 * MiB;
constexpr size_t WS_END = 488 * MiB;
static_assert(P_END <= WS_BM && WS_MIX + (size_t)MTOK * MIXW * 2 <= WS_END && WS_P + (size_t)MTOK * 3072 * 2 <= WS_Y && WS_Y + (size_t)MTOK * DM * 2 <= WS_MIX, "ws map");
constexpr int CW_Q = 64;
constexpr int CW_BAR = 4096;

constexpr int RING_BYTES = 131072, MISC_OFF = RING_BYTES + 320, LDS_BYTES = 155648;

#define RLX_AGENT __ATOMIC_RELAXED, __HIP_MEMORY_SCOPE_AGENT
#define LDS_WAIT() asm volatile("s_waitcnt lgkmcnt(0)" ::: "memory")
#define VM_WAIT() asm volatile("s_waitcnt vmcnt(0)" ::: "memory")
__device__ __forceinline__ unsigned f2bf(float f) { unsigned u = __builtin_bit_cast(unsigned, f); return (u + 0x7fffu + ((u >> 16) & 1u)) >> 16; }
__device__ __forceinline__ unsigned pk2(float lo, float hi) { return f2bf(lo) | (f2bf(hi) << 16); }
__device__ __forceinline__ float bf2f(unsigned short b) { return __builtin_bit_cast(float, ((unsigned)b) << 16); }
typedef __bf16 bf16x2_t __attribute__((ext_vector_type(2)));
__device__ __forceinline__ unsigned cvtpk(float lo, float hi) { f32x2 v = {lo, hi}; bf16x2_t b = __builtin_convertvector(v, bf16x2_t); return __builtin_bit_cast(unsigned, b); }
__device__ __forceinline__ float lane_get_f(float v, int src_lane) { return __builtin_bit_cast(float, __builtin_amdgcn_ds_bpermute(src_lane << 2, __builtin_bit_cast(int, v))); }
__device__ __forceinline__ unsigned lane_get_u(unsigned v, int src_lane) { return (unsigned)__builtin_amdgcn_ds_bpermute(src_lane << 2, (int)v); }
__device__ __forceinline__ float wave_sum(float v, int lane) {
#pragma unroll
    for (int o = 1; o < 64; o <<= 1) v += lane_get_f(v, lane ^ o);
    return v;
}
template <class T> __device__ __forceinline__ T* launder(T* p) { GAS T* g = (GAS T*)p; asm volatile("" : "+s"(g)); return (T*)g; }
__device__ __forceinline__ int launder_v(int v) { asm volatile("" : "+v"(v)); return v; }
__device__ __forceinline__ int launder_i(int v) { asm volatile("" : "+s"(v)); return v; }
__device__ __forceinline__ int tid_from_wave(int wave) { const unsigned m = (unsigned)launder_i(-1); return launder_i(wave) * 64 + (int)__builtin_amdgcn_mbcnt_hi(m, __builtin_amdgcn_mbcnt_lo(m, 0u)); }
__device__ __forceinline__ int crow(int r, int hi) { return (r & 3) + 8 * (r >> 2) + 4 * hi; }

#define XB_TMO      128
#define XB_XCNT(j)  (256  + 64 * (j))
#define XB_XSUB(j)  (1280 + 64 * (j))
#define XB_XGEN(j)  (2304 + 64 * (j))
#define XB_TOP      3328
#define XB_TOPGEN   3392
#define XCD_BAR_WORDS 3456
#define XB_SPIN_CAP (1u << 22)
__device__ __forceinline__ unsigned xb_ld(unsigned* p)              { return __hip_atomic_load(p, __ATOMIC_RELAXED, __HIP_MEMORY_SCOPE_AGENT); }
__device__ __forceinline__ unsigned xb_add(unsigned* p, unsigned v) { return __hip_atomic_fetch_add(p, v, __ATOMIC_RELAXED, __HIP_MEMORY_SCOPE_AGENT); }
__device__ __forceinline__ unsigned xb_xcc_id() { return (unsigned)__builtin_amdgcn_s_getreg((3 << 11) | 20) & 0xFu; }
#define XB_SPIN(cond, bar) do { unsigned _sp = 0; while (cond) { __builtin_amdgcn_s_sleep(1); \
    if ((++_sp & 255u) == 0u) { if (xb_ld(&(bar)[XB_TMO])) break; if (_sp > XB_SPIN_CAP) { atomicAdd(&(bar)[XB_TMO], 1u); break; } } } } while (0)
struct XcdBarrier { unsigned* bar; unsigned x; volatile LAS unsigned* st; };
__device__ __forceinline__ XcdBarrier xcd_barrier_post(unsigned* bar, volatile LAS unsigned* st, int tid) {
    XcdBarrier b; b.bar = bar; b.x = xb_xcc_id(); b.st = st;
    if (tid == 0) (void)xb_add(&bar[XB_XCNT(b.x)], 1u);
    return b;
}
__device__ __forceinline__ void xcd_barrier_complete(unsigned* bar, unsigned x, unsigned& nloc, unsigned& nx) {
    const unsigned G = gridDim.x * gridDim.y * gridDim.z;
    unsigned sum, cnt, mine, sp = 0u;
    for (;;) {
        sum = 0u; cnt = 0u; mine = 0u;
#pragma unroll
        for (unsigned j = 0; j < 16; ++j) { const unsigned c = xb_ld(&bar[XB_XCNT(j)]); sum += c; cnt += (c > 0u) ? 1u : 0u; mine = (j == x) ? c : mine; }
        if (sum == G) break;
        __builtin_amdgcn_s_sleep(1);
        if ((++sp & 255u) == 0u) { if (xb_ld(&bar[XB_TMO])) break; if (sp > XB_SPIN_CAP) { atomicAdd(&bar[XB_TMO], 1u); break; } }
    }
    nloc = mine > 0u ? mine : 1u; nx = cnt > 0u ? cnt : 1u;
}
__device__ __forceinline__ void xcd_barrier(const XcdBarrier& b, int tid) {
    asm volatile("s_waitcnt vmcnt(0)" ::: "memory");
    __syncthreads();
    if (tid == 0) {
        unsigned* bar = b.bar;
        __builtin_amdgcn_s_waitcnt(0);
        unsigned nloc = b.st[0], nx = b.st[1];
        if (nloc == 0u) { xcd_barrier_complete(bar, b.x, nloc, nx); b.st[0] = nloc; b.st[1] = nx; }
        const unsigned old = xb_add(&bar[XB_XSUB(b.x)], 1u);
        const unsigned gen = old / nloc;
        if (old + 1u == (gen + 1u) * nloc) {
            __builtin_amdgcn_fence(__ATOMIC_RELEASE, "agent");
            asm volatile("s_waitcnt vmcnt(0)" ::: "memory");
            const unsigned og = xb_add(&bar[XB_TOP], 1u);
            const unsigned tg = og / nx;
            if (og + 1u == (tg + 1u) * nx) xb_add(&bar[XB_TOPGEN], 1u);
            else XB_SPIN(xb_ld(&bar[XB_TOPGEN]) == tg, bar);
            __builtin_amdgcn_fence(__ATOMIC_ACQUIRE, "agent");
            xb_add(&bar[XB_XGEN(b.x)], 1u);
            asm volatile("s_waitcnt vmcnt(0)" ::: "memory");
        } else {
            XB_SPIN(xb_ld(&bar[XB_XGEN(b.x)]) == gen, bar);
            __builtin_amdgcn_fence(__ATOMIC_ACQUIRE, "agent");
            asm volatile("s_waitcnt vmcnt(0)" ::: "memory");
        }
    }
    __syncthreads();
}

namespace pg8 {
constexpr int BM = 256, BK = 64, HALF = 128, HTB = HALF * BK * 2, STAGE_BYTES = 8 * HTB, NXCD = 8, WGM = 8;
__host__ __device__ __forceinline__ int lds_byte(int r, int c) { const int st = (r >> 4) * 2 + (c >> 5), rr = r & 15, cc = c & 31, ob = rr * 64 + cc * 2; return st * 1024 + (ob ^ (((ob >> 9) & 1) << 5)); }
__host__ __device__ __forceinline__ void stage_rc(int b, int& R, int& C) { const int st = b / 1024, sb = b % 1024, swz = sb ^ (((sb >> 9) & 1) << 5); R = (st >> 1) * 16 + swz / 64; C = (st & 1) * 32 + (swz % 64) / 2; }
__host__ __device__ __forceinline__ int perm32(int rho) { const int n = rho >> 4, i = rho & 15; return 8 * (i >> 2) + 4 * n + (i & 3); }
struct Unit { int pm, pn; };
struct Gemm { const bf16_t* A; const bf16_t* Bt; int M, N, K, lda, ldb, agt, ags; };
struct StaticOrder {
    int nM, nN, nwg, G, c, trip;
    __host__ __device__ __forceinline__ void init(int M, int N, int G_, int c_, int trip_ = 0) { nM = M / BM; nN = N / BM; trip = trip_; if (trip) nN /= 3; nwg = nM * nN; G = G_; c = c_; }
    __host__ __device__ __forceinline__ bool next(int i, Unit& u) const {
        if (trip) { const int br = i % 3; if (!next1(i / 3, u)) return false; u.pn = 3 * u.pn + br; return true; }
        return next1(i, u);
    }
    __host__ __device__ __forceinline__ bool next1(int i, Unit& u) const {
        const long L = (long)i * G + c; if (L >= nwg) return false;
        int wgid = (int)L; { const int q = nwg / NXCD, r = nwg % NXCD, xcd = wgid % NXCD, off = wgid / NXCD; wgid = (xcd < r ? xcd * (q + 1) : r * (q + 1) + (xcd - r) * q) + off; }
        const int nig = WGM * nN, gid = wgid / nig, fm = gid * WGM, gsz = (nM - fm) < WGM ? (nM - fm) : WGM;
        u.pm = fm + ((wgid % nig) % gsz); u.pn = (wgid % nig) / gsz; return true;
    }
};

#ifndef GEMM_INL
#define GEMM_INL __forceinline__
#endif
template <class Epi>
__device__ GEMM_INL void gemm_phase(LAS unsigned char* lds, const Gemm g, const StaticOrder& S, const Epi& E, int tid_) {
    const int tid = launder_v(tid_), wid = __builtin_amdgcn_readfirstlane(tid >> 6), lane = tid & 63, wr = wid >> 2, wc = wid & 3, fr = lane & 15, fq = lane >> 4;
    int Kop = g.K; asm volatile("" : "+s"(Kop));
    const int nt = Kop / BK;
    unsigned voffA[2], voffB[2];
#pragma unroll
    for (int i = 0; i < 2; ++i) { int R, C; stage_rc(tid * 16 + i * 8192, R, C); const int Rb = Epi::PERM ? ((R & ~31) + perm32(R & 31)) : R;
        voffA[i] = (unsigned)(R * g.lda + C) * 2u; voffB[i] = (unsigned)(Rb * g.ldb + C) * 2u; }
    const size_t kstep = (size_t)(BK * 2);
    const size_t hstepA = (size_t)HALF * g.lda * 2, hstepB = (size_t)HALF * g.ldb * 2;
    const size_t tstepA = 2 * hstepA, tstepB = 2 * hstepB;
    const unsigned ldsw = (unsigned)wid * 1024u;
    const int aoff = lds_byte(wr * 64 + fr, fq * 8), boff = lds_byte(wc * 32 + fr, fq * 8);
#define PG8_SA(b, h) (((b) * 2 + (h)) * HTB)
#define PG8_SB(b, h) ((4 + (b) * 2 + (h)) * HTB)
#define PG8_STAGE(bufoff, gbase, voff) do { _Pragma("unroll") for (int _i = 0; _i < 2; ++_i) \
        __builtin_amdgcn_global_load_lds((const unsigned*)((const char*)(gbase) + (voff)[_i]), (LAS unsigned*)(lds + (bufoff) + ldsw + _i * 8192), 16, 0, 0); } while (0)
#define PG8_LDA(dst, b, h) do { _Pragma("unroll") for (int m = 0; m < 4; ++m) _Pragma("unroll") for (int k = 0; k < 2; ++k) dst[m][k] = *(const LAS bf16x8*)(lds + PG8_SA(b, h) + aoff + m * 2048 + k * 1024); } while (0)
#define PG8_LDB(dst, b, h) do { _Pragma("unroll") for (int n = 0; n < 2; ++n) _Pragma("unroll") for (int k = 0; k < 2; ++k) dst[n][k] = *(const LAS bf16x8*)(lds + PG8_SB(b, h) + boff + n * 2048 + k * 1024); } while (0)
#define PG8_MMA(ai, bj, At, Bt) do { __builtin_amdgcn_s_setprio(1); _Pragma("unroll") for (int m = 0; m < 4; ++m) _Pragma("unroll") for (int n = 0; n < 2; ++n) _Pragma("unroll") for (int k = 0; k < 2; ++k) \
        acc[ai][bj][m][n] = __builtin_amdgcn_mfma_f32_16x16x32_bf16(Bt[n][k], At[m][k], acc[ai][bj][m][n], 0, 0, 0); __builtin_amdgcn_s_setprio(0); } while (0)
#define PG8_WAIT_V(n) asm volatile("s_waitcnt vmcnt(" #n ")" ::: "memory")
#define PG8_WAIT_L(n) asm volatile("s_waitcnt lgkmcnt(" #n ")" ::: "memory")
#define PG8_BAR __builtin_amdgcn_s_barrier()
#define PG8_SCHED __builtin_amdgcn_sched_barrier(0)
#define PG8_APTR(u) ((const char*)g.A + (size_t)(u).pm * tstepA + (g.agt ? (size_t)((u).pn / g.agt) * (size_t)g.ags : (size_t)0))
    Unit cur, nxt; int ui = 0;
    if (!S.next(0, cur)) return;
    f32x4 acc[2][2][4][2];
#pragma unroll
    for (int a = 0; a < 2; ++a)
#pragma unroll
        for (int b = 0; b < 2; ++b)
#pragma unroll
            for (int m = 0; m < 4; ++m)
#pragma unroll
                for (int n = 0; n < 2; ++n) acc[a][b][m][n] = (f32x4){0.f, 0.f, 0.f, 0.f};
    bf16x8 At[4][2], B0[2][2], B1[2][2];
    const char* cA = PG8_APTR(cur); const char* cB = (const char*)g.Bt + (size_t)cur.pn * tstepB;
    PG8_STAGE(PG8_SB(0, 0), cB, voffB); PG8_STAGE(PG8_SB(0, 1), cB + hstepB, voffB); PG8_STAGE(PG8_SA(0, 0), cA, voffA); PG8_STAGE(PG8_SA(0, 1), cA + hstepA, voffA);
    if (wr == 1) PG8_BAR;
    PG8_WAIT_V(2); PG8_BAR;
    PG8_STAGE(PG8_SB(1, 0), cB + kstep, voffB); PG8_STAGE(PG8_SA(1, 0), cA + kstep, voffA); PG8_STAGE(PG8_SB(1, 1), cB + hstepB + kstep, voffB);
    PG8_WAIT_V(6); PG8_BAR;
    for (;;) {
        const bool has_next = S.next(ui + 1, nxt);
        const char* nA = has_next ? PG8_APTR(nxt) : cA; const char* nB = has_next ? (const char*)g.Bt + (size_t)nxt.pn * tstepB : cB;
        for (int t = 0; t < nt; t += 2) {
            const bool last = (t == nt - 2);
            const char* a1 = cA + (size_t)(t + 1) * kstep;
            const char* a2 = last ? nA : cA + (size_t)(t + 2) * kstep; const char* b2 = last ? nB : cB + (size_t)(t + 2) * kstep;
            const char* a3 = a2 + kstep; const char* b3 = b2 + kstep;
            PG8_LDB(B0, 0, 0); PG8_LDB(B1, 0, 1); PG8_SCHED; PG8_LDA(At, 0, 0); PG8_STAGE(PG8_SA(1, 1), a1 + hstepA, voffA);
            PG8_WAIT_V(8); PG8_WAIT_L(0); PG8_BAR; PG8_MMA(0, 0, At, B0); PG8_MMA(0, 1, At, B1); PG8_BAR; PG8_SCHED;
            PG8_LDA(At, 0, 1); PG8_STAGE(PG8_SB(0, 0), b2, voffB); PG8_STAGE(PG8_SB(0, 1), b2 + hstepB, voffB); PG8_STAGE(PG8_SA(0, 0), a2, voffA);
            PG8_WAIT_V(8); PG8_WAIT_L(0); PG8_BAR; PG8_MMA(1, 0, At, B0); PG8_MMA(1, 1, At, B1); PG8_BAR; PG8_SCHED;
            PG8_LDB(B0, 1, 0); PG8_LDB(B1, 1, 1); PG8_SCHED; PG8_LDA(At, 1, 0); PG8_STAGE(PG8_SA(0, 1), a2 + hstepA, voffA);
            PG8_WAIT_V(8); PG8_WAIT_L(0); PG8_BAR; PG8_MMA(0, 0, At, B0); PG8_MMA(0, 1, At, B1); PG8_BAR; PG8_SCHED;
            PG8_LDA(At, 1, 1); PG8_STAGE(PG8_SB(1, 0), b3, voffB); PG8_STAGE(PG8_SB(1, 1), b3 + hstepB, voffB); PG8_STAGE(PG8_SA(1, 0), a3, voffA);
            PG8_WAIT_V(8); PG8_WAIT_L(0); PG8_BAR; PG8_MMA(1, 0, At, B0); PG8_MMA(1, 1, At, B1); PG8_BAR; PG8_SCHED;
        }
        if (wr == 0) PG8_BAR;
        { const unsigned m_ = (unsigned)launder_i(-1); const int ln_ = (int)__builtin_amdgcn_mbcnt_hi(m_, __builtin_amdgcn_mbcnt_lo(m_, 0u));
          E(acc, cur, wr, wc, ln_ & 15, ln_ >> 4); }
        if (!has_next) break;
#pragma unroll
        for (int a = 0; a < 2; ++a)
#pragma unroll
            for (int b = 0; b < 2; ++b)
#pragma unroll
                for (int m = 0; m < 4; ++m)
#pragma unroll
                    for (int n = 0; n < 2; ++n) acc[a][b][m][n] = (f32x4){0.f, 0.f, 0.f, 0.f};
        cur = nxt; cA = nA; cB = nB; ++ui;
        if (wr == 1) PG8_BAR;
    }
    PG8_WAIT_V(0);
    PG8_BAR;
#undef PG8_SA
#undef PG8_SB
#undef PG8_STAGE
#undef PG8_LDA
#undef PG8_LDB
#undef PG8_MMA
#undef PG8_WAIT_V
#undef PG8_WAIT_L
#undef PG8_BAR
#undef PG8_SCHED
#undef PG8_APTR
}

template <bool IN16, bool OUT16>
struct EpiRes {
    static constexpr bool PERM = true;
    const void* xin; void* xout; const float* gate;
    bf16_t* xs; const float* gn; const float* scp; float* ss;
    __device__ __forceinline__ void operator()(const f32x4 (&acc)[2][2][4][2], const Unit& u, int wr, int wc, int fr, int fq) const {
        const int row0 = u.pm * BM + wr * 64 + fr, col0 = u.pn * BM + wc * 32 + 8 * fq;
        const float* gp = gate + (size_t)(u.pm >> 5) * 6144;
        f32x4 gv[2][2], gm[2][2];
#pragma unroll
        for (int bj = 0; bj < 2; ++bj)
#pragma unroll
            for (int n = 0; n < 2; ++n) { gv[bj][n] = *(const f32x4*)(gp + col0 + bj * HALF + n * 4);
                if (xs) gm[bj][n] = *(const f32x4*)(gn + col0 + bj * HALF + n * 4) * (*(const f32x4*)(scp + (size_t)(u.pm >> 5) * 6144 + col0 + bj * HALF + n * 4) + 1.0f); }
        constexpr int MB = IN16 ? 4 : 2;
#pragma unroll
        for (int aim = 0; aim < 8; aim += MB) { const int ai = aim >> 2;
            u32x4 xi[4][2]; f32x4 xf[4][2][2];
#pragma unroll
            for (int m = aim & 3; m < (aim & 3) + MB; ++m) { const size_t off = (size_t)(row0 + ai * HALF + m * 16) * DM + col0;
#pragma unroll
                for (int bj = 0; bj < 2; ++bj) {
                    if (IN16) xi[m][bj] = *(const u32x4*)((const bf16_t*)xin + off + bj * HALF);
                    else { xf[m][bj][0] = *(const f32x4*)((const float*)xin + off + bj * HALF); xf[m][bj][1] = *(const f32x4*)((const float*)xin + off + bj * HALF + 4); } } }
            asm volatile("" ::: "memory");
#pragma unroll
            for (int m = aim & 3; m < (aim & 3) + MB; ++m) { const size_t row = (size_t)(row0 + ai * HALF + m * 16), off = row * DM + col0; float sq = 0.f;
#pragma unroll
                for (int bj = 0; bj < 2; ++bj) { u32x4 o, yo; f32x4 xv[2];
                    if (IN16) { const u32x4 x4 = xi[m][bj];
                        xv[0] = (f32x4){bf2f(x4.x & 0xffff), bf2f(x4.x >> 16), bf2f(x4.y & 0xffff), bf2f(x4.y >> 16)}; xv[1] = (f32x4){bf2f(x4.z & 0xffff), bf2f(x4.z >> 16), bf2f(x4.w & 0xffff), bf2f(x4.w >> 16)}; }
                    else { xv[0] = xf[m][bj][0]; xv[1] = xf[m][bj][1]; }
#pragma unroll
                    for (int n = 0; n < 2; ++n) {
                        const f32x4 y = xv[n] + gv[bj][n] * acc[ai][bj][m][n];
                        if (OUT16) { yo[2 * n] = cvtpk(y[0], y[1]); yo[2 * n + 1] = cvtpk(y[2], y[3]); }
                        else *(f32x4*)((float*)xout + off + bj * HALF + n * 4) = y;
                        if (xs) { const f32x4 z = y * gm[bj][n]; o[2 * n] = cvtpk(z[0], z[1]); o[2 * n + 1] = cvtpk(z[2], z[3]); }
                        if (ss) sq += (y[0] * y[0] + y[1] * y[1]) + (y[2] * y[2] + y[3] * y[3]); }
                    if (OUT16) *(u32x4*)((bf16_t*)xout + off + bj * HALF) = yo;
                    if (xs) *(u32x4*)(xs + off + bj * HALF) = o; }
                if (ss) { sq += lane_get_f(sq, (fr + 16 * fq) ^ 16); sq += lane_get_f(sq, (fr + 16 * fq) ^ 32);
                    if (fq == 0) atomicAdd(ss + row, sq); } } }
    }
};
struct EpiPlain {
    static constexpr bool PERM = true;
    bf16_t* O; int ldc;
    __device__ __forceinline__ void operator()(const f32x4 (&acc)[2][2][4][2], const Unit& u, int wr, int wc, int fr, int fq) const {
        const int row0 = u.pm * BM + wr * 64 + fr, col0 = u.pn * BM + wc * 32 + 8 * fq;
#pragma unroll
        for (int ai = 0; ai < 2; ++ai)
#pragma unroll
            for (int m = 0; m < 4; ++m) { bf16_t* rowp = O + (size_t)(row0 + ai * HALF + m * 16) * ldc + col0;
#pragma unroll
                for (int bj = 0; bj < 2; ++bj) { const f32x4 v0 = acc[ai][bj][m][0], v1 = acc[ai][bj][m][1];
                    u32x4 w; w.x = cvtpk(v0[0], v0[1]); w.y = cvtpk(v0[2], v0[3]); w.z = cvtpk(v1[0], v1[1]); w.w = cvtpk(v1[2], v1[3]);
                    *(u32x4*)(rowp + bj * HALF) = w; } }
    }
};
__device__ __forceinline__ float sigm(float x) { return __builtin_amdgcn_rcpf(1.0f + __builtin_amdgcn_exp2f(-x * LOG2E)); }
struct EpiGate {
    static constexpr bool PERM = true;
    const bf16_t* Z; bf16_t* Y; const float* bias; const float* ss;
    __device__ __forceinline__ void operator()(const f32x4 (&acc)[2][2][4][2], const Unit& u, int wr, int wc, int fr, int fq) const {
        const int cp = u.pn / 3, kk = u.pn - 3 * cp, cin = wc * 32 + 8 * fq;
        const int row0 = u.pm * BM + wr * 64 + fr;
        int zcol[2], ycol[2];
#pragma unroll
        for (int bj = 0; bj < 2; ++bj) { const int br = kk == 2 ? 2 : bj, blk = kk == 2 ? 2 * cp + bj : 2 * cp + kk; ycol[bj] = blk * 128 + cin; zcol[bj] = br * 1024 + ycol[bj]; }
        f32x4 bv[2][2];
#pragma unroll
        for (int bj = 0; bj < 2; ++bj)
#pragma unroll
            for (int n = 0; n < 2; ++n) bv[bj][n] = *(const f32x4*)(bias + (size_t)(u.pm >> 5) * NCB1 + u.pn * BM + bj * HALF + cin + 4 * n) * (-LOG2E);
#pragma unroll
        for (int ai = 0; ai < 2; ++ai) {
            float ssr[4]; u32x4 zz[4][2], yy[4][2];
#pragma unroll
            for (int m = 0; m < 4; ++m) { const size_t row = (size_t)(row0 + ai * HALF + m * 16);
                ssr[m] = ss[row];
#pragma unroll
                for (int bj = 0; bj < 2; ++bj) { zz[m][bj] = *(const u32x4*)(Z + row * 3072 + zcol[bj]); if (kk == 2) yy[m][bj] = *(const u32x4*)(Y + row * DM + ycol[bj]); } }
            asm volatile("" ::: "memory");
#pragma unroll
            for (int m = 0; m < 4; ++m) { const size_t row = (size_t)(row0 + ai * HALF + m * 16);
                const float rs = __builtin_amdgcn_rsqf(ssr[m] * (1.0f / DM) + RMS_EPS) * (-LOG2E);
                float t[2][8];
#pragma unroll
                for (int bj = 0; bj < 2; ++bj) { const f32x4 v0 = acc[ai][bj][m][0] * rs + bv[bj][0], v1 = acc[ai][bj][m][1] * rs + bv[bj][1];
                    const u32x4 z = zz[m][bj];
#define SG_(x) __builtin_amdgcn_rcpf(1.0f + __builtin_amdgcn_exp2f(x))
                    t[bj][0] = SG_(v0[0]) * bf2f(z.x & 0xffff); t[bj][1] = SG_(v0[1]) * bf2f(z.x >> 16); t[bj][2] = SG_(v0[2]) * bf2f(z.y & 0xffff); t[bj][3] = SG_(v0[3]) * bf2f(z.y >> 16);
                    t[bj][4] = SG_(v1[0]) * bf2f(z.z & 0xffff); t[bj][5] = SG_(v1[1]) * bf2f(z.z >> 16); t[bj][6] = SG_(v1[2]) * bf2f(z.w & 0xffff); t[bj][7] = SG_(v1[3]) * bf2f(z.w >> 16);
#undef SG_
                }
                if (kk == 2) {
#pragma unroll
                    for (int bj = 0; bj < 2; ++bj) { const u32x4 y = yy[m][bj];
                        t[bj][0] += bf2f(y.x & 0xffff); t[bj][1] += bf2f(y.x >> 16); t[bj][2] += bf2f(y.y & 0xffff); t[bj][3] += bf2f(y.y >> 16);
                        t[bj][4] += bf2f(y.z & 0xffff); t[bj][5] += bf2f(y.z >> 16); t[bj][6] += bf2f(y.w & 0xffff); t[bj][7] += bf2f(y.w >> 16);
                        u32x4 w; w.x = cvtpk(t[bj][0], t[bj][1]); w.y = cvtpk(t[bj][2], t[bj][3]); w.z = cvtpk(t[bj][4], t[bj][5]); w.w = cvtpk(t[bj][6], t[bj][7]);
                        *(u32x4*)(Y + row * DM + ycol[bj]) = w; }
                } else {
                    u32x4 w; w.x = cvtpk(t[0][0] + t[1][0], t[0][1] + t[1][1]); w.y = cvtpk(t[0][2] + t[1][2], t[0][3] + t[1][3]);
                    w.z = cvtpk(t[0][4] + t[1][4], t[0][5] + t[1][5]); w.w = cvtpk(t[0][6] + t[1][6], t[0][7] + t[1][7]);
                    *(u32x4*)(Y + row * DM + ycol[0]) = w; } } }
    }
};
struct EpiSwiGLU {
    static constexpr bool PERM = true;
    bf16_t* O; const float* bias; const float* ss;
    __device__ __forceinline__ void operator()(const f32x4 (&acc)[2][2][4][2], const Unit& u, int wr, int wc, int fr, int fq) const {
        const int row0 = u.pm * BM + wr * 64 + fr, col0 = u.pn * HALF + wc * 32 + 8 * fq;
        const float* bp = bias + (size_t)(u.pm >> 5) * NCB2 + u.pn * BM + wc * 32 + 8 * fq;
        const f32x4 bg0 = *(const f32x4*)bp, bg1 = *(const f32x4*)(bp + 4), bu0 = *(const f32x4*)(bp + HALF), bu1 = *(const f32x4*)(bp + HALF + 4);
        float ssr[2][4];
#pragma unroll
        for (int ai = 0; ai < 2; ++ai)
#pragma unroll
            for (int m = 0; m < 4; ++m) ssr[ai][m] = ss[row0 + ai * HALF + m * 16];
        asm volatile("" ::: "memory");
#pragma unroll
        for (int ai = 0; ai < 2; ++ai)
#pragma unroll
            for (int m = 0; m < 4; ++m) { const size_t row = (size_t)(row0 + ai * HALF + m * 16); bf16_t* rowp = O + row * FFH + col0;
                const float rs = __builtin_amdgcn_rsqf(ssr[ai][m] * (1.0f / DM) + RMS_EPS);
                const f32x4 g0 = acc[ai][0][m][0] * rs + bg0, g1 = acc[ai][0][m][1] * rs + bg1, u0 = acc[ai][1][m][0] * rs + bu0, u1 = acc[ai][1][m][1] * rs + bu1;
                u32x4 w; w.x = cvtpk(g0[0] * sigm(g0[0]) * u0[0], g0[1] * sigm(g0[1]) * u0[1]); w.y = cvtpk(g0[2] * sigm(g0[2]) * u0[2], g0[3] * sigm(g0[3]) * u0[3]);
                w.z = cvtpk(g1[0] * sigm(g1[0]) * u1[0], g1[1] * sigm(g1[1]) * u1[1]); w.w = cvtpk(g1[2] * sigm(g1[2]) * u1[2], g1[3] * sigm(g1[3]) * u1[3]);
                *(u32x4*)rowp = w; }
    }
};
struct EpiProj {
    static constexpr bool PERM = true;
    unsigned char* ws; const float* bias_; const float* ss; const int* pos;
    __device__ __forceinline__ void operator()(const f32x4 (&acc)[2][2][4][2], const Unit& u, int wr, int wc, int fr, int fq) const {
        const int row0 = u.pm * BM + wr * 64 + fr; const float* bias = bias_ + (size_t)(u.pm >> 5) * NCB1;
        float rsv[2][4], posf[2][4];
        const f32x4 inv4 = (fq & 1) ? (f32x4){0.0014142135623842478f, 0.00027424818836152554f, 5.3182957344688475e-05f, 1.0313385246263351e-05f}
                                    : (f32x4){1.0f, 0.1939227432012558f, 0.03760603070259094f, 0.007292664609849453f};
#pragma unroll
        for (int ai = 0; ai < 2; ++ai)
#pragma unroll
            for (int m = 0; m < 4; ++m) { rsv[ai][m] = __builtin_amdgcn_rsqf(ss[row0 + ai * HALF + m * 16] * (1.0f / DM) + RMS_EPS); posf[ai][m] = (float)pos[row0 + ai * HALF + m * 16]; }
#pragma unroll
        for (int bj = 0; bj < 2; ++bj) {
            const int g = u.pn * 8 + bj * 4 + wc;
            if (g >= 115) continue;
            size_t dofs; int ld, col; bool rope = false; float sc = 1.0f;
            if (g < 12)       { dofs = P_QA; ld = 384; col = g * 32; rope = !(g & 1); sc = QSCALE; }
            else if (g < 24)  { dofs = P_KA; ld = 384; col = (g - 12) * 32; rope = !(g & 1); }
            else if (g < 36)  { dofs = P_VA; ld = 384; col = (g - 24) * 32; }
            else if (g < 52)  { dofs = P_QI; ld = 512; col = (g - 36) * 32; rope = !(g & 1); }
            else if (g < 54)  { dofs = P_KI; ld = 64; col = (g - 52) * 32; rope = (g == 52); }
            else if (g == 54) { dofs = 0; ld = 0; col = 0; }
            else if (g < 65)  { dofs = P_QB; ld = 320; col = (g - 55) * 32; sc = QSCALE; }
            else if (g < 75)  { dofs = P_KB; ld = 320; col = (g - 65) * 32; }
            else if (g < 85)  { dofs = P_VB; ld = 320; col = (g - 75) * 32; }
            else if (g < 95)  { dofs = P_QC; ld = 320; col = (g - 85) * 32; sc = QSCALE; }
            else if (g < 105) { dofs = P_KC; ld = 320; col = (g - 95) * 32; }
            else              { dofs = P_VC; ld = 320; col = (g - 105) * 32; }
            const f32x4 bv0 = *(const f32x4*)(bias + g * 32 + 8 * fq), bv1 = *(const f32x4*)(bias + g * 32 + 8 * fq + 4);
            if (g == 54) {
                float* WI = (float*)(ws + WS_WI); float* FC = (float*)(ws + WS_FC);
#pragma unroll
                for (int ai = 0; ai < 2; ++ai)
#pragma unroll
                    for (int m = 0; m < 4; ++m) { const size_t row = (size_t)(row0 + ai * HALF + m * 16);
                        const f32x4 v0 = acc[ai][bj][m][0] * rsv[ai][m] + bv0, v1 = acc[ai][bj][m][1] * rsv[ai][m] + bv1;
                        if (fq == 0) { *(f32x4*)(WI + row * 8) = v0 * WI_SCALE; *(f32x4*)(WI + row * 8 + 4) = v1 * WI_SCALE; }
                        else if (fq == 1) { float o[8];
#pragma unroll
                            for (int j = 0; j < 8; ++j) { const float x = j < 4 ? v0[j & 3] : v1[j & 3]; o[j] = fminf(x, 0.f) - log1pf(expf(-fabsf(x))); }
                            *(f32x4*)(FC + row * 8) = (f32x4){o[0], o[1], o[2], o[3]}; *(f32x4*)(FC + row * 8 + 4) = (f32x4){o[4], o[5], o[6], o[7]}; } }
                continue;
            }
            bf16_t* dst = (bf16_t*)(ws + dofs);
#pragma unroll
            for (int ai = 0; ai < 2; ++ai)
#pragma unroll
                for (int m = 0; m < 4; ++m) { const size_t row = (size_t)(row0 + ai * HALF + m * 16);
                    f32x4 v0 = acc[ai][bj][m][0] * rsv[ai][m] + bv0, v1 = acc[ai][bj][m][1] * rsv[ai][m] + bv1;
                    if (rope && fq < 2) {
                        f32x4 cs, sn;
#pragma unroll
                        for (int j = 0; j < 4; ++j) { const float ang = posf[ai][m] * inv4[j]; const float rev = ang * 0.15915493667125702f; const float fr = __builtin_amdgcn_fractf(rev);
                            cs[j] = __builtin_amdgcn_cosf(fr); sn[j] = __builtin_amdgcn_sinf(fr); }
                        f32x4 o0, o1;
                        o0[0] = v0[0] * cs[0] - v0[1] * sn[0]; o0[1] = v0[1] * cs[0] + v0[0] * sn[0];
                        o0[2] = v0[2] * cs[1] - v0[3] * sn[1]; o0[3] = v0[3] * cs[1] + v0[2] * sn[1];
                        o1[0] = v1[0] * cs[2] - v1[1] * sn[2]; o1[1] = v1[1] * cs[2] + v1[0] * sn[2];
                        o1[2] = v1[2] * cs[3] - v1[3] * sn[3]; o1[3] = v1[3] * cs[3] + v1[2] * sn[3];
                        v0 = o0; v1 = o1; }
                    v0 = v0 * sc; v1 = v1 * sc;
                    u32x4 w; w.x = cvtpk(v0[0], v0[1]); w.y = cvtpk(v0[2], v0[3]); w.z = cvtpk(v1[0], v1[1]); w.w = cvtpk(v1[2], v1[3]);
                    *(u32x4*)(dst + row * ld + col + 8 * fq) = w; }
        }
    }
};
}

__host__ __device__ __forceinline__ int map_p1(int n) {
    const int g = n >> 5, p = n & 31;
    const int pr = p < 16 ? ((p >> 1) + 8 * (p & 1)) : p;
    if (g < 12) return SRC_QA + g * 32 + ((g & 1) ? p : pr);
    if (g < 24) return SRC_KA + (g - 12) * 32 + ((g & 1) ? p : pr);
    if (g < 36) return SRC_VA + (g - 24) * 32 + p;
    if (g < 52) return SRC_QI + (g - 36) * 32 + ((g & 1) ? p : pr);
    if (g < 54) return SRC_KI + (g - 52) * 32 + ((g == 52) ? pr : p);
    if (g == 54) return p < 8 ? SRC_WI + p : (p < 13 ? SRC_F + (p - 8) : -1);
    if (g < 85) return SRC_B + (g - 55) * 32 + p;
    if (g < 115) return SRC_C + (g - 85) * 32 + p;
    return -1;
}
__host__ __device__ __forceinline__ int map_gate(int n) { const int t = n >> 8, w = n & 255, bj = w >> 7, cw = w & 127, cp = t / 3, kk = t % 3;
    const int br = kk == 2 ? 2 : bj, blk = kk == 2 ? 2 * cp + bj : 2 * cp + kk; return br * 1024 + blk * 128 + cw; }
__host__ __device__ __forceinline__ int map_f1(int r) { const int t = r >> 8, w = r & 255; return w < 128 ? 128 * t + w : FFH + 128 * t + (w - 128); }

struct Args { const void* in[15]; float* out; unsigned char* ws; int ph_lo, ph_hi; };
struct Frame {
    LAS unsigned char* lds; unsigned* ctl; unsigned char* ws;
    int tid, lane, wave, G, bid;
};

template <class CM>
__device__ __forceinline__ void transpose_item(const float* src, int ldsrc, int kvalid, bf16_t* dst, int lddst, int n0, int k0, LAS float* scr, int lane, CM cm) {
    const int sc = cm(n0 + (lane & 31));
#pragma unroll 8
    for (int i = 0; i < 32; ++i) { const int kk = 2 * i + (lane >> 5); const int k = k0 + kk;
        scr[kk * 33 + (lane & 31)] = (sc >= 0 && k < kvalid) ? src[(size_t)k * ldsrc + sc] : 0.f; }
    LDS_WAIT(); asm volatile("" ::: "memory");
    const int c = lane & 7;
#pragma unroll
    for (int j = 0; j < 4; ++j) { const int n = (lane >> 3) + 8 * j; const LAS float* s = scr + (8 * c) * 33 + n;
        u32x4 o; o.x = pk2(s[0 * 33], s[1 * 33]); o.y = pk2(s[2 * 33], s[3 * 33]); o.z = pk2(s[4 * 33], s[5 * 33]); o.w = pk2(s[6 * 33], s[7 * 33]);
        *(u32x4*)(dst + (size_t)(n0 + n) * lddst + k0 + 8 * c) = o; }
    LDS_WAIT(); asm volatile("" ::: "memory");
}
typedef float f32x4_u __attribute__((ext_vector_type(4), aligned(4)));
template <class CM>
__device__ __forceinline__ void transpose_item_vec(const float* src, int ldsrc, int kvalid, bf16_t* dst, int lddst, int n0, int k0, int lane, CM cm) {
    const int ln = lane & 7, lk = lane >> 3, sc = cm(n0 + 4 * ln), kb = k0 + 8 * lk;
    f32x4 v[8];
#pragma unroll
    for (int j = 0; j < 8; ++j) v[j] = (kb + j < kvalid) ? (f32x4)(*(const f32x4_u*)(src + (size_t)(kb + j) * ldsrc + sc)) : (f32x4){0.f, 0.f, 0.f, 0.f};
#pragma unroll
    for (int i = 0; i < 4; ++i) { u32x4 o; o.x = pk2(v[0][i], v[1][i]); o.y = pk2(v[2][i], v[3][i]); o.z = pk2(v[4][i], v[5][i]); o.w = pk2(v[6][i], v[7][i]);
        *(u32x4*)(dst + (size_t)(n0 + 4 * ln + i) * lddst + kb) = o; }
}
struct CmP1 { __device__ int operator()(int n) const { return map_p1(n); } };
struct CmOff { int off; __device__ int operator()(int n) const { return off + n; } };
struct CmF1 { __device__ int operator()(int n) const { return map_f1(n); } };

__device__ __forceinline__ void phase_prologue(Frame& F, const void* const (&ain)[15]) {
    const float* c_in = (const float*)ain[1]; const int* pos = (const int*)ain[2];
    const float* ada_w = (const float*)ain[3]; const float* ada_b = (const float*)ain[4];
    const float* w_in = (const float*)ain[6]; const float* b_in = (const float*)ain[7];
    const float* w_branch = (const float*)ain[9]; const float* w_out = (const float*)ain[10];
    const float* w_f1 = (const float*)ain[12]; const float* w_f2 = (const float*)ain[13];
    LAS float* scr = (LAS float*)(F.lds + F.wave * 16384);
    const int gw = F.bid * 8 + F.wave, NGW = F.G * 8;
    constexpr int I_P1 = 16 * (NP1 / 32), I_P2 = 16 * (NP2 / 32), I_BR = 3 * 6 * 32, I_OUT = 16 * 32, I_F1 = 16 * (2 * FFH / 32), I_F2 = (FFH / 64) * 32;
    constexpr int I_LAYER = I_P1 + I_P2 + I_BR + I_OUT + I_F1 + I_F2;
    for (int it = gw; it < DEPTH * I_LAYER; it += NGW) {
        const int l = it / I_LAYER; int r = it % I_LAYER;
        unsigned char* wl = F.ws + WS_W + (size_t)l * W_LAYER;
        if (r < I_P1) { const int nb = r % (NP1 / 32), kb = r / (NP1 / 32);
            const bool plain = (nb >= 24 && nb < 36) || (nb >= 55 && nb < 115) || ((nb & 1) && nb < 54);
            if (plain) transpose_item_vec(w_in + (size_t)l * DM * IN_W, IN_W, DM, (bf16_t*)(wl + W_P1), DM, nb * 32, kb * 64, F.lane, CmP1{});
            else transpose_item(w_in + (size_t)l * DM * IN_W, IN_W, DM, (bf16_t*)(wl + W_P1), DM, nb * 32, kb * 64, scr, F.lane, CmP1{});
            continue; } r -= I_P1;
        if (r < I_P2) { const int nb = r % (NP2 / 32), kb = r / (NP2 / 32); transpose_item_vec(w_in + (size_t)l * DM * IN_W, IN_W, DM, (bf16_t*)(wl + W_P2), DM, nb * 32, kb * 64, F.lane, CmOff{SRC_G + map_gate(nb * 32) - nb * 32}); continue; } r -= I_P2;
        if (r < I_BR) { const int br = r / 192, rr = r % 192, nb = rr % 32, kb = rr / 32; const int kofs = br == 0 ? 0 : (br == 1 ? 384 : 704), kv = br == 0 ? 384 : 320;
            transpose_item_vec(w_branch + (size_t)l * DM * DM + (size_t)kofs * DM, DM, kv, (bf16_t*)(wl + W_BR) + (size_t)br * 1024 * KBR, KBR, nb * 32, kb * 64, F.lane, CmOff{0}); continue; } r -= I_BR;
        if (r < I_OUT) { const int nb = r % 32, kb = r / 32;
            transpose_item_vec(w_out + (size_t)l * DM * DM, DM, DM, (bf16_t*)(wl + W_OUT), DM, nb * 32, kb * 64, F.lane, CmOff{0}); continue; } r -= I_OUT;
        if (r < I_F1) { const int nb = r % (2 * FFH / 32), kb = r / (2 * FFH / 32); transpose_item_vec(w_f1 + (size_t)l * DM * 2 * FFH, 2 * FFH, DM, (bf16_t*)(wl + W_F1), DM, nb * 32, kb * 64, F.lane, CmF1{}); continue; } r -= I_F1;
        { const int nb = r % 32, kb = r / 32; transpose_item_vec(w_f2 + (size_t)l * FFH * DM, DM, FFH, (bf16_t*)(wl + W_F2), FFH, nb * 32, kb * 64, F.lane, CmOff{0}); }
    }
    __syncthreads();
    {
        LAS float* red = (LAS float*)F.lds;
        LAS float* cs = (LAS float*)(F.lds + 8192);
        for (int i = F.tid; i < 4096; i += 512) { const float x = c_in[i]; cs[i] = x / (1.0f + expf(-x)); }
        __syncthreads();
        float* mod = (float*)(F.ws + WS_MOD);
        for (int it = F.bid; it < DEPTH * 96; it += F.G) {
            const int l = it / 96, j = (it % 96) * 64 + (F.tid & 63), ks = F.tid >> 6;
            const float* wp = ada_w + (size_t)l * DM * 6144 + (size_t)(ks * 128) * 6144 + j;
            float s0 = 0.f, s1 = 0.f, s2 = 0.f, s3 = 0.f;
#pragma unroll 8
            for (int k = 0; k < 128; ++k) { const float w = wp[(size_t)k * 6144]; const int kk = ks * 128 + k;
                s0 += w * cs[kk]; s1 += w * cs[1024 + kk]; s2 += w * cs[2048 + kk]; s3 += w * cs[3072 + kk]; }
            red[(ks * 64 + (F.tid & 63)) * 4 + 0] = s0; red[(ks * 64 + (F.tid & 63)) * 4 + 1] = s1; red[(ks * 64 + (F.tid & 63)) * 4 + 2] = s2; red[(ks * 64 + (F.tid & 63)) * 4 + 3] = s3;
            __syncthreads();
            if (F.tid < 256) { const int jj = F.tid & 63, bb = F.tid >> 6; float s = ada_b[l * 6144 + (it % 96) * 64 + jj];
#pragma unroll
                for (int q = 0; q < 8; ++q) s += red[(q * 64 + jj) * 4 + bb];
                mod[((size_t)l * 4 + bb) * 6144 + (it % 96) * 64 + jj] = s; }
            __syncthreads();
        }
    }
    {
        float* bp1 = (float*)(F.ws + WS_BP1); float* bp2 = (float*)(F.ws + WS_BP2);
        for (int i = F.bid * 512 + F.tid; i < DEPTH * NP1; i += F.G * 512) { const int l = i / NP1, n = i % NP1, s = map_p1(n); bp1[i] = s >= 0 ? b_in[l * IN_W + s] : 0.f; }
        for (int i = F.bid * 512 + F.tid; i < DEPTH * NP2; i += F.G * 512) { const int l = i / NP2, n = i % NP2; bp2[i] = b_in[l * IN_W + SRC_G + map_gate(n)]; }
    }
}

__device__ __forceinline__ void phase_norm(Frame& F, const float* x, const float* g, const float* modb  , int sh_off, int sc_off, bf16_t* h) {
    const int gw = F.bid * 8 + F.wave, NGW = F.G * 8;
    for (int m = gw; m < MTOK; m += NGW) {
        const float* mb = modb + (size_t)(m >> 13) * 6144;
        const f32x4* xr = (const f32x4*)(x + (size_t)m * DM) + F.lane;
        f32x4 v[4]; float s = 0.f;
#pragma unroll
        for (int j = 0; j < 4; ++j) { v[j] = xr[64 * j]; s += (v[j].x * v[j].x + v[j].y * v[j].y) + (v[j].z * v[j].z + v[j].w * v[j].w); }
        const float rstd = 1.0f / sqrtf(wave_sum(s, F.lane) * (1.0f / DM) + RMS_EPS);
        u32x2* o8 = (u32x2*)(h + (size_t)m * DM) + F.lane;
#pragma unroll
        for (int j = 0; j < 4; ++j) { const int c = 4 * F.lane + 256 * j;
            const f32x4 gg = *(const f32x4*)(g + c), sc = *(const f32x4*)(mb + sc_off + c), sh = *(const f32x4*)(mb + sh_off + c);
            const f32x4 y = (v[j] * rstd * gg) * (sc + 1.0f) + sh;
            u32x2 o; o.x = pk2(y.x, y.y); o.y = pk2(y.z, y.w); o8[64 * j] = o; }
    }
}
__device__ __forceinline__ void phase_first(Frame& F, const float* x, const float* g1, const float* mod  , const float* n2g_unused) {
    const int gw = F.bid * 8 + F.wave, NGW = F.G * 8; (void)n2g_unused;
    bf16_t* XS = (bf16_t*)(F.ws + WS_H); float* SS = (float*)(F.ws + WS_SS);
    for (int m0 = gw; m0 < MTOK; m0 += 2 * NGW) {
        const int m1 = m0 + NGW < MTOK ? m0 + NGW : m0;
        f32x4 v[2][4]; float s[2] = {0.f, 0.f};
#pragma unroll
        for (int q = 0; q < 2; ++q) { const f32x4* xr = (const f32x4*)(x + (size_t)(q ? m1 : m0) * DM) + F.lane;
#pragma unroll
            for (int j = 0; j < 4; ++j) v[q][j] = xr[64 * j]; }
#pragma unroll
        for (int q = 0; q < 2; ++q) {
#pragma unroll
            for (int j = 0; j < 4; ++j) s[q] += (v[q][j].x * v[q][j].x + v[q][j].y * v[q][j].y) + (v[q][j].z * v[q][j].z + v[q][j].w * v[q][j].w);
            s[q] = wave_sum(s[q], F.lane); }
#pragma unroll
        for (int q = 0; q < 2; ++q) { const int m = q ? m1 : m0; if (q && m1 == m0) break;
            const float* mb = mod + (size_t)(m >> 13) * 6144;
            if (F.lane < 4) SS[(size_t)F.lane * MTOK + m] = F.lane == 0 ? s[q] : 0.f;
            if (F.lane == 4) ((float*)(F.ws + WS_SSF))[m] = 0.f;
            u32x2* o8 = (u32x2*)(XS + (size_t)m * DM) + F.lane;
#pragma unroll
            for (int j = 0; j < 4; ++j) { const int c = 4 * F.lane + 256 * j;
                const f32x4 gg = *(const f32x4*)(g1 + c), sc = *(const f32x4*)(mb + 1024 + c);
                const f32x4 y = v[q][j] * gg * (sc + 1.0f);
                u32x2 o; o.x = pk2(y.x, y.y); o.y = pk2(y.z, y.w); o8[64 * j] = o; } }
    }
    float* CB = (float*)(F.ws + WS_CB);
    const float* bp1 = (const float*)(F.ws + WS_BP1); const float* bp2 = (const float*)(F.ws + WS_BP2);
    constexpr int NIT = DEPTH * (NCB1 + NCB2);
    for (int it = gw; it < NIT; it += NGW) {
        const int l = it / (NCB1 + NCB2), r = it % (NCB1 + NCB2);
        const unsigned char* wl = F.ws + WS_W + (size_t)l * W_LAYER;
        const bf16_t* wrow; float bias; int shoff; float* dst; int dstride;
        if (r < NP1) { wrow = (const bf16_t*)(wl + W_P1) + (size_t)r * DM; bias = bp1[l * NP1 + r]; shoff = 0; dst = CB + (size_t)l * 4 * NCB1 + r; dstride = NCB1; }
        else if (r < NCB1) { wrow = (const bf16_t*)(wl + W_P2) + (size_t)(r - NP1) * DM; bias = bp2[l * NP2 + (r - NP1)]; shoff = 0; dst = CB + (size_t)l * 4 * NCB1 + r; dstride = NCB1; }
        else { wrow = (const bf16_t*)(wl + W_F1) + (size_t)(r - NCB1) * DM; bias = 0.f; shoff = 3072; dst = CB + CB2_OFF + (size_t)l * 4 * NCB2 + (r - NCB1); dstride = NCB2; }
        const u32x4 w0 = *(const u32x4*)(wrow + F.lane * 8), w1 = *(const u32x4*)(wrow + 512 + F.lane * 8);
        float wv[16];
#pragma unroll
        for (int e = 0; e < 4; ++e) { wv[2 * e] = bf2f(w0[e] & 0xffff); wv[2 * e + 1] = bf2f(w0[e] >> 16); wv[8 + 2 * e] = bf2f(w1[e] & 0xffff); wv[9 + 2 * e] = bf2f(w1[e] >> 16); }
        float dd[4];
#pragma unroll
        for (int bb = 0; bb < 4; ++bb) { const float* sh = mod + ((size_t)l * 4 + bb) * 6144 + shoff;
            const f32x4 a0 = *(const f32x4*)(sh + F.lane * 8), a1 = *(const f32x4*)(sh + F.lane * 8 + 4), c0 = *(const f32x4*)(sh + 512 + F.lane * 8), c1 = *(const f32x4*)(sh + 512 + F.lane * 8 + 4);
            dd[bb] = a0[0] * wv[0] + a0[1] * wv[1] + a0[2] * wv[2] + a0[3] * wv[3] + a1[0] * wv[4] + a1[1] * wv[5] + a1[2] * wv[6] + a1[3] * wv[7]
                    + c0[0] * wv[8] + c0[1] * wv[9] + c0[2] * wv[10] + c0[3] * wv[11] + c1[0] * wv[12] + c1[1] * wv[13] + c1[2] * wv[14] + c1[3] * wv[15]; }
#pragma unroll
        for (int bb = 0; bb < 4; ++bb) dd[bb] = wave_sum(dd[bb], F.lane);
        if (F.lane < 4) dst[(size_t)F.lane * dstride] = (F.lane == 0 ? dd[0] : F.lane == 1 ? dd[1] : F.lane == 2 ? dd[2] : dd[3]) + bias;
    }
}
__device__ __forceinline__ void phase_final_norm(Frame& F, float* out, const float* g) {
    const int gw = F.bid * 8 + F.wave, NGW = F.G * 8;
    const bf16_t* Y = (const bf16_t*)(F.ws + WS_Y); const float* SSF = (const float*)(F.ws + WS_SSF);
    f32x4 gg[4];
#pragma unroll
    for (int j = 0; j < 4; ++j) gg[j] = *(const f32x4*)(g + 16 * F.lane + 4 * j);
    for (int m = gw; m < MTOK; m += 2 * NGW) {
        const int m1 = m + NGW < MTOK ? m + NGW : m;
        const u32x4 a0 = *((const u32x4*)(Y + (size_t)m * DM) + 2 * F.lane), a1 = *((const u32x4*)(Y + (size_t)m * DM) + 2 * F.lane + 1);
        const u32x4 c0 = *((const u32x4*)(Y + (size_t)m1 * DM) + 2 * F.lane), c1 = *((const u32x4*)(Y + (size_t)m1 * DM) + 2 * F.lane + 1);
        const float r0 = __builtin_amdgcn_rsqf(SSF[m] * (1.0f / DM) + RMS_EPS), r1 = __builtin_amdgcn_rsqf(SSF[m1] * (1.0f / DM) + RMS_EPS);
#define FN_ROW(mm, p0, p1, rr) do { f32x4* orow = (f32x4*)(out + (size_t)(mm) * DM + 16 * F.lane); \
            orow[0] = (f32x4){bf2f(p0.x & 0xffff), bf2f(p0.x >> 16), bf2f(p0.y & 0xffff), bf2f(p0.y >> 16)} * (rr) * gg[0]; orow[1] = (f32x4){bf2f(p0.z & 0xffff), bf2f(p0.z >> 16), bf2f(p0.w & 0xffff), bf2f(p0.w >> 16)} * (rr) * gg[1]; \
            orow[2] = (f32x4){bf2f(p1.x & 0xffff), bf2f(p1.x >> 16), bf2f(p1.y & 0xffff), bf2f(p1.y >> 16)} * (rr) * gg[2]; orow[3] = (f32x4){bf2f(p1.z & 0xffff), bf2f(p1.z >> 16), bf2f(p1.w & 0xffff), bf2f(p1.w >> 16)} * (rr) * gg[3]; } while (0)
        FN_ROW(m, a0, a1, r0);
        if (m1 != m) FN_ROW(m1, c0, c1, r1);
#undef FN_ROW
    }
}

namespace att {
constexpr int NSLOT = 4, L_K = 0, L_V = 32768, L_AUX = 65536, L_TAB = 73728, L_WS = 74816, L_OST = 76864, L_END = 109632;
static_assert(L_END <= RING_BYTES, "attention LDS");
enum { ATT_A = 0, ATT_B = 1, ATT_C = 2 };
constexpr float NEG = -1.0e30f;
__device__ __forceinline__ s16x4 vtr(const LAS unsigned char* p) { typedef short v4i16_t __attribute__((ext_vector_type(4)));
    return __builtin_bit_cast(s16x4, __builtin_amdgcn_ds_read_tr16_b64_v4i16((LAS v4i16_t*)p)); }
__device__ __forceinline__ float max3f(float a, float b, float c) { float r; asm("v_max3_f32 %0, %1, %2, %3" : "=v"(r) : "v"(a), "v"(b), "v"(c)); return r; }
template <int POS> __device__ __forceinline__ float bitsel(unsigned w, float a, float b) { int m; float o;
    asm("v_bfe_i32 %0, %1, %2, 1" : "=v"(m) : "v"(w), "n"(POS)); asm("v_bfi_b32 %0, %1, %2, %3" : "=v"(o) : "v"(m), "v"(a), "v"(b)); return o; }
#define ATT_WAITBAR(n) asm volatile("s_waitcnt vmcnt(" #n ") lgkmcnt(0)\n\ts_barrier" ::: "memory")

template <int TYPE, int DUMMY = 0>
__device__ __forceinline__ void attn_unit(LAS unsigned char* lds, const bf16_t* __restrict__ Qp, const bf16_t* __restrict__ Kp, const bf16_t* __restrict__ Vp, int ld,
                                          bf16_t* Op, int b, int h, int qb, const unsigned* aux, const float* relb, int tid_) {
    const int tid = launder_v(tid_), lane = tid & 63, r32 = lane & 31, hi = lane >> 5;
    const int wid = __builtin_amdgcn_readfirstlane(tid >> 6);
    const size_t rowbase = (size_t)b * SEQ;
    const int q0 = qb * 256, qw0 = q0 + wid * 32, cq = qw0 >> 6;
    int t_lo = 0; const int t_hi = 4 * (qb + 1);
    if (TYPE == ATT_B) { t_lo = 4 * qb - 8; if (t_lo < 0) t_lo = 0; }
    int a_lo = t_lo, a_hi = cq;
    if (TYPE == ATT_B) { a_lo = cq - 8 > t_lo ? cq - 8 : t_lo; }
    if (TYPE == ATT_C) {
        const float* fn = (const float*)aux + (size_t)(b * 5 + h) * SEQ; const float lim = fn[q0] - 2.0f * relb[0] - 43.0f;
        const bool c0 = (lane < t_hi) && (fn[64 * lane + 63] < lim), c1 = (lane + 64 < t_hi) && (fn[64 * (lane + 64) + 63] < lim);
        t_lo = ((int)__builtin_popcountll(__ballot(c0)) + (int)__builtin_popcountll(__ballot(c1))) & ~1;
        if (t_lo > t_hi - 4) t_lo = t_hi - 4;
        a_lo = t_lo; a_hi = (qw0 + 31) >> 6; }
    bf16x8 qf[4];
    { const bf16_t* Qw = Qp + (rowbase + qw0 + r32) * ld + h * 64 + hi * 8;
#pragma unroll
      for (int d0 = 0; d0 < 4; ++d0) qf[d0] = *(const bf16x8*)(Qw + d0 * 16); }
    const bf16_t* ksrc = Kp + (rowbase + lane) * ld + h * 64 + wid * 8;
    const bf16_t* vsrc = Vp + (rowbase + 16 * (wid & 3) + (lane >> 2)) * ld + h * 64 + (wid >> 2) * 32 + (lane & 3) * 8;
    const unsigned* asrc = aux;
    if (TYPE == ATT_A) asrc = aux + ((size_t)(b * 256 + qb * 8 + wid) * 128) * 64 + lane;
    if (TYPE == ATT_C) asrc = aux + (size_t)(b * 5 + h) * SEQ + lane;
    LAS unsigned char* auxl = lds + L_AUX + wid * 1024;
#define ATT_DMA(t) do { const int sl_ = (t) & (NSLOT - 1); \
        __builtin_amdgcn_global_load_lds((const unsigned*)(ksrc + (size_t)(t) * 64 * ld), (LAS unsigned*)(lds + L_K + sl_ * 8192 + wid * 1024), 16, 0, 0); \
        __builtin_amdgcn_global_load_lds((const unsigned*)(vsrc + (size_t)(t) * 64 * ld), (LAS unsigned*)(lds + L_V + sl_ * 8192 + wid * 1024), 16, 0, 0); \
        if (TYPE != ATT_B) __builtin_amdgcn_global_load_lds(asrc + (size_t)(t) * 64, (LAS unsigned*)(auxl + sl_ * 256), 4, 0, 0); } while (0)
#define ATT_SYNC(younger) do { if (TYPE == ATT_B) { if ((younger) >= 2) ATT_WAITBAR(4); else if ((younger) == 1) ATT_WAITBAR(2); else ATT_WAITBAR(0); } \
        else { if ((younger) >= 2) ATT_WAITBAR(6); else if ((younger) == 1) ATT_WAITBAR(3); else ATT_WAITBAR(0); } } while (0)
    LAS float* wsf = (LAS float*)(lds + L_WS) + wid * 64;
    LAS float* tab = (LAS float*)(lds + L_TAB);
    if (TYPE == ATT_B) { if (tid < 257) tab[tid] = relb[tid] * LOG2E; }
    ATT_DMA(t_lo); if (t_lo + 1 < t_hi) ATT_DMA(t_lo + 1); if (t_lo + 2 < t_hi) ATT_DMA(t_lo + 2);
    float mhat = NEG, lsum = 0.f; f32x16 o0 = {}, o1 = {};
#define ATT_QK(P0, P1, t, ref) do { const int s_ = (t) & (NSLOT - 1); \
        if (TYPE == ATT_C) { const LAS float* kb = (const LAS float*)(auxl + s_ * 256); \
            _Pragma("unroll") for (int g4 = 0; g4 < 4; ++g4) { const f32x4 a_ = *(const LAS f32x4*)(kb + 8 * g4 + 4 * hi), c_ = *(const LAS f32x4*)(kb + 32 + 8 * g4 + 4 * hi); \
                _Pragma("unroll") for (int j_ = 0; j_ < 4; ++j_) { P0[4 * g4 + j_] = a_[j_] - (ref); P1[4 * g4 + j_] = c_[j_] - (ref); } } \
        } else if (TYPE == ATT_B) { const int dc = cq - (t); \
            if (dc >= 3) { const float cb = tab[256] - (ref); _Pragma("unroll") for (int r = 0; r < 16; ++r) { P0[r] = cb; P1[r] = cb; } } \
            else { const int dq = 64 * dc + (qw0 & 63) + r32; \
                _Pragma("unroll") for (int r = 0; r < 16; ++r) { int d0_ = dq - crow(r, hi), d1_ = d0_ - 32; d0_ = d0_ > 128 ? 128 : d0_; d1_ = d1_ > 128 ? 128 : d1_; \
                    P0[r] = tab[d0_ + 128] - (ref); P1[r] = tab[d1_ + 128] - (ref); } } \
        } else { const u32x2 mq = *(const LAS u32x2*)(auxl + s_ * 256 + r32 * 8); const unsigned w0 = mq.x >> (4 * hi), w1 = mq.y >> (4 * hi); const float nref = -(ref), negv = NEG; \
            P0[0] = bitsel<0>(w0, nref, negv); P1[0] = bitsel<0>(w1, nref, negv); P0[1] = bitsel<1>(w0, nref, negv); P1[1] = bitsel<1>(w1, nref, negv); P0[2] = bitsel<2>(w0, nref, negv); P1[2] = bitsel<2>(w1, nref, negv); P0[3] = bitsel<3>(w0, nref, negv); P1[3] = bitsel<3>(w1, nref, negv); P0[4] = bitsel<8>(w0, nref, negv); P1[4] = bitsel<8>(w1, nref, negv); P0[5] = bitsel<9>(w0, nref, negv); P1[5] = bitsel<9>(w1, nref, negv); P0[6] = bitsel<10>(w0, nref, negv); P1[6] = bitsel<10>(w1, nref, negv); P0[7] = bitsel<11>(w0, nref, negv); P1[7] = bitsel<11>(w1, nref, negv); P0[8] = bitsel<16>(w0, nref, negv); P1[8] = bitsel<16>(w1, nref, negv); P0[9] = bitsel<17>(w0, nref, negv); P1[9] = bitsel<17>(w1, nref, negv); P0[10] = bitsel<18>(w0, nref, negv); P1[10] = bitsel<18>(w1, nref, negv); P0[11] = bitsel<19>(w0, nref, negv); P1[11] = bitsel<19>(w1, nref, negv); P0[12] = bitsel<24>(w0, nref, negv); P1[12] = bitsel<24>(w1, nref, negv); P0[13] = bitsel<25>(w0, nref, negv); P1[13] = bitsel<25>(w1, nref, negv); P0[14] = bitsel<26>(w0, nref, negv); P1[14] = bitsel<26>(w1, nref, negv); P0[15] = bitsel<27>(w0, nref, negv); P1[15] = bitsel<27>(w1, nref, negv); } \
        if (!(DUMMY & 16)) { const LAS unsigned char* kb_ = lds + L_K + s_ * 8192 + hi * 1024 + r32 * 16; \
            _Pragma("unroll") for (int d0 = 0; d0 < 4; ++d0) { const bf16x8 k0 = *(const LAS bf16x8*)(kb_ + d0 * 2048), k1 = *(const LAS bf16x8*)(kb_ + d0 * 2048 + 512); \
                P0 = __builtin_amdgcn_mfma_f32_32x32x16_bf16(k0, qf[d0], P0, 0, 0, 0); P1 = __builtin_amdgcn_mfma_f32_32x32x16_bf16(k1, qf[d0], P1, 0, 0, 0); } } \
        if (TYPE == ATT_C) { if (64 * (t) + 63 > qw0) { const int qq = qw0 + r32 - 64 * (t); \
            _Pragma("unroll") for (int r = 0; r < 16; ++r) { const int kk = crow(r, hi); if (kk > qq) P0[r] = NEG; if (kk + 32 > qq) P1[r] = NEG; } } } \
    } while (0)
    f32x16 pc0, pc1, pn0, pn1; float refc = 0.f, refn = 0.f;
    ATT_SYNC(t_hi - 1 - t_lo);
    if (a_lo == t_lo) { refc = 0.f; ATT_QK(pc0, pc1, t_lo, refc); }
#define ATT_STEP(t, C0, C1, RC, N0, N1, RN) do { \
          \
        if ((t) + 1 < t_hi) { if ((t) + 2 < t_hi) ATT_SYNC(1); else ATT_SYNC(0); if ((t) + 3 < t_hi) ATT_DMA((t) + 3); } \
        const bool act = ((t) >= a_lo) && ((t) <= a_hi), actn = ((t) + 1 >= a_lo) && ((t) + 1 <= a_hi) && ((t) + 1 < t_hi); \
        if (actn) { RN = mhat < -1.0e29f ? 0.f : mhat; ATT_QK(N0, N1, (t) + 1, RN); } \
        if (act) { \
            const int s = (t) & (NSLOT - 1); \
            if (!(DUMMY & 2)) { \
            float ra = max3f(C0[0], C0[1], C1[0]), rb = max3f(C0[2], C0[3], C1[1]); ra = max3f(ra, C1[2], C1[3]); \
            _Pragma("unroll") for (int r = 4; r < 16; r += 4) { ra = max3f(ra, C0[r], C0[r + 1]); rb = max3f(rb, C0[r + 2], C0[r + 3]); ra = max3f(ra, C1[r], C1[r + 1]); rb = max3f(rb, C1[r + 2], C1[r + 3]); } \
            float rm = fmaxf(ra, rb); \
            { const u32x2 rr = __builtin_amdgcn_permlane32_swap(__float_as_uint(rm), __float_as_uint(rm), false, false); rm = fmaxf(__uint_as_float(rr[0]), __uint_as_float(rr[1])); } \
            const float mnew = fmaxf(mhat, rm + RC); \
            if (__any(mnew != RC)) {                   \
                const float f = __builtin_amdgcn_exp2f(mhat - mnew), dl = RC - mnew; \
                lsum *= f; \
                _Pragma("unroll") for (int r = 0; r < 16; ++r) { C0[r] += dl; C1[r] += dl; } \
                if (hi == 0) wsf[r32] = f; \
                LDS_WAIT(); \
                _Pragma("unroll") for (int g4 = 0; g4 < 4; ++g4) { const f32x4 fv = *(const LAS f32x4*)(wsf + 8 * g4 + 4 * hi); \
                    _Pragma("unroll") for (int j = 0; j < 4; ++j) { o0[4 * g4 + j] *= fv[j]; o1[4 * g4 + j] *= fv[j]; } } \
            } \
            mhat = mnew; \
            float ps = 0.f; \
            _Pragma("unroll") for (int r = 0; r < 16; ++r) { C0[r] = __builtin_amdgcn_exp2f(C0[r]); C1[r] = __builtin_amdgcn_exp2f(C1[r]); ps += C0[r] + C1[r]; } \
            lsum += ps; \
            } \
            u32x4 pw[4]; \
            _Pragma("unroll") for (int j = 0; j < 4; ++j) { pw[0][j] = cvtpk(C0[2 * j], C0[2 * j + 1]); pw[1][j] = cvtpk(C0[8 + 2 * j], C0[9 + 2 * j]); pw[2][j] = cvtpk(C1[2 * j], C1[2 * j + 1]); pw[3][j] = cvtpk(C1[8 + 2 * j], C1[9 + 2 * j]); } \
            const LAS unsigned char* vp = lds + L_V + s * 8192 + ((lane >> 4) & 1) * 32 + (lane & 3) * 8 + (4 * hi + ((lane & 15) >> 2)) * 64; \
            if (DUMMY & 16) { asm volatile("" :: "v"(pw[0]), "v"(pw[1]), "v"(pw[2]), "v"(pw[3])); } \
            else { \
            _Pragma("unroll") for (int ks = 0; ks < 4; ++ks) { \
                const s16x4 a0 = vtr(vp + ks * 1024), a1 = vtr(vp + ks * 1024 + 512), c0 = vtr(vp + 4096 + ks * 1024), c1 = vtr(vp + 4096 + ks * 1024 + 512); \
                const bf16x8 v0 = (bf16x8){a0[0], a0[1], a0[2], a0[3], a1[0], a1[1], a1[2], a1[3]}, v1 = (bf16x8){c0[0], c0[1], c0[2], c0[3], c1[0], c1[1], c1[2], c1[3]}; \
                const bf16x8 pa = __builtin_bit_cast(bf16x8, pw[ks]); \
                o0 = __builtin_amdgcn_mfma_f32_32x32x16_bf16(pa, v0, o0, 0, 0, 0); \
                o1 = __builtin_amdgcn_mfma_f32_32x32x16_bf16(pa, v1, o1, 0, 0, 0); \
            } } \
        } \
    } while (0)
    for (int t = t_lo; t < t_hi; t += 2) {
        ATT_STEP(t, pc0, pc1, refc, pn0, pn1, refn);
        ATT_STEP(t + 1, pn0, pn1, refn, pc0, pc1, refc);
    }
#undef ATT_STEP
    { const u32x2 rr = __builtin_amdgcn_permlane32_swap(__float_as_uint(lsum), __float_as_uint(lsum), false, false); lsum = __uint_as_float(rr[0]) + __uint_as_float(rr[1]); }
    if (hi == 0) wsf[32 + r32] = lsum;
    LDS_WAIT();
    LAS bf16_t* stg = (LAS bf16_t*)(lds + L_OST) + wid * 2048;
#pragma unroll
    for (int g4 = 0; g4 < 4; ++g4) { const f32x4 lv = *(const LAS f32x4*)(wsf + 32 + 8 * g4 + 4 * hi);
#pragma unroll
        for (int j = 0; j < 4; ++j) { const int r = 4 * g4 + j, orow = crow(r, hi); const float rl = __builtin_amdgcn_rcpf(lv[j]);
            stg[orow * 64 + r32] = (bf16_t)f2bf(o0[r] * rl); stg[orow * 64 + 32 + r32] = (bf16_t)f2bf(o1[r] * rl); } }
    LDS_WAIT();
    bf16_t* Ow = Op + (rowbase + qw0) * MIXW;
    if (DUMMY) { const u32x4 v = *(const LAS u32x4*)(stg + (lane >> 3) * 64 + (lane & 7) * 8); asm volatile("" :: "v"(v)); }
    else
#pragma unroll
    for (int i = 0; i < 4; ++i) { const int row = i * 8 + (lane >> 3), ch = lane & 7; const u32x4 v = *(const LAS u32x4*)(stg + row * 64 + ch * 8); *(u32x4*)(Ow + (size_t)row * MIXW + ch * 8) = v; }
    if (TYPE != ATT_A) { if (h == 4) {
        bf16_t* Oz = Op + (rowbase + qw0) * MIXW + 64;
#pragma unroll
        for (int i = 0; i < 4; ++i) { const int row = i * 8 + (lane >> 3), ch = lane & 7; *(u32x4*)(Oz + (size_t)row * MIXW + ch * 8) = (u32x4){0u, 0u, 0u, 0u}; } } }
    VM_WAIT(); __syncthreads();
#undef ATT_DMA
#undef ATT_SYNC
#undef ATT_QK
}
}

namespace att2 {
constexpr int NSLOT = 3, SLOTB = 8192;
constexpr int L_K = 0, L_V = NSLOT * SLOTB, L_AUX = 2 * NSLOT * SLOTB, L_WS = L_AUX + 8 * 768, L_OST = L_WS + 8 * 256, L_END = L_OST + 8 * 4096;
static_assert(L_END <= RING_BYTES, "attention LDS");
enum { T_A = 0, T_C = 2 };
#define SBAR() __builtin_amdgcn_sched_barrier(0)
#define WAIT_BAR(N) asm volatile("s_waitcnt vmcnt(" #N ") lgkmcnt(0)\n\ts_barrier" ::: "memory")
__device__ __forceinline__ void glds16(const void* gsrc, unsigned lds_dst) { unsigned keep;
    asm volatile("s_mov_b32 %0, m0\n\ts_mov_b32 m0, %2\n\ts_nop 0\n\tglobal_load_lds_dwordx4 %1, off\n\ts_mov_b32 m0, %0" : "=&s"(keep) : "v"(gsrc), "s"(lds_dst) : "memory"); }
__device__ __forceinline__ void glds4(const void* gsrc, unsigned lds_dst) { unsigned keep;
    asm volatile("s_mov_b32 %0, m0\n\ts_mov_b32 m0, %2\n\ts_nop 0\n\tglobal_load_lds_dword %1, off\n\ts_mov_b32 m0, %0" : "=&s"(keep) : "v"(gsrc), "s"(lds_dst) : "memory"); }
__device__ __forceinline__ void kload8(bf16x8* kf, const LAS unsigned char* kp) {
    kf[0] = *(const LAS bf16x8*)(kp);        kf[1] = *(const LAS bf16x8*)(kp + 512);  kf[2] = *(const LAS bf16x8*)(kp + 2048); kf[3] = *(const LAS bf16x8*)(kp + 2560);
    kf[4] = *(const LAS bf16x8*)(kp + 4096); kf[5] = *(const LAS bf16x8*)(kp + 4608); kf[6] = *(const LAS bf16x8*)(kp + 6144); kf[7] = *(const LAS bf16x8*)(kp + 6656); }
__device__ __forceinline__ void kload2(bf16x8* kf, const LAS unsigned char* kp, int j) { kf[2 * j] = *(const LAS bf16x8*)(kp + j * 2048); kf[2 * j + 1] = *(const LAS bf16x8*)(kp + j * 2048 + 512); }
__device__ __forceinline__ void cmask(f32x16& p0, f32x16& p1, int jb, int qrel, int hi) {
    const float NEG = -__builtin_inff(); const int kb = 64 * jb + 4 * hi;
#pragma unroll
    for (int r = 0; r < 16; ++r) { const int kv = kb + (r & 3) + 8 * (r >> 2); if (kv > qrel) p0[r] = NEG; if (kv + 32 > qrel) p1[r] = NEG; }
}
__device__ __forceinline__ void pv(f32x16* o, int vb, bf16x8 pa0, bf16x8 pa1, bf16x8 pa2, bf16x8 pa3) {
#pragma unroll
    for (int d0 = 0; d0 < 2; ++d0) { s16x4 lo[4], hi[4];
#pragma unroll
        for (int ks = 0; ks < 4; ++ks) {
            asm volatile("ds_read_b64_tr_b16 %0,%1 offset:%c2" : "=&v"(lo[ks]) : "v"(vb), "i"(d0 * 4096 + ks * 1024) : "memory");
            asm volatile("ds_read_b64_tr_b16 %0,%1 offset:%c2" : "=&v"(hi[ks]) : "v"(vb), "i"(d0 * 4096 + ks * 1024 + 512) : "memory"); }
        asm volatile("s_waitcnt lgkmcnt(0)" ::: "memory"); SBAR();
#define PK(k) (bf16x8){lo[k][0], lo[k][1], lo[k][2], lo[k][3], hi[k][0], hi[k][1], hi[k][2], hi[k][3]}
        o[d0] = __builtin_amdgcn_mfma_f32_32x32x16_bf16(pa0, PK(0), o[d0], 0, 0, 0);
        o[d0] = __builtin_amdgcn_mfma_f32_32x32x16_bf16(pa1, PK(1), o[d0], 0, 0, 0);
        o[d0] = __builtin_amdgcn_mfma_f32_32x32x16_bf16(pa2, PK(2), o[d0], 0, 0, 0);
        o[d0] = __builtin_amdgcn_mfma_f32_32x32x16_bf16(pa3, PK(3), o[d0], 0, 0, 0);
#undef PK
    }
}

template <int TYPE, int LD, int THRL>
__device__ __forceinline__ void attn_unit(LAS unsigned char* lds, const bf16_t* __restrict__ Qp, const bf16_t* __restrict__ Kp, const bf16_t* __restrict__ Vp, bf16_t* Op, int b, int h, int qb,
                                          const unsigned* aux, const float* relb, int tid_) {
    const int tid = launder_v(tid_), lane = tid & 63, r32 = lane & 31, hi = lane >> 5;
    const int wid = __builtin_amdgcn_readfirstlane(tid >> 6);
    const size_t rowbase = (size_t)b * SEQ; const int q0 = qb * 256;
    int t_lo = 0; const int t_hi = 4 * (qb + 1);
    if (TYPE == T_C) {
        const float* fn = (const float*)aux + (size_t)(b * 5 + h) * SEQ; const float lim = fn[q0] - 2.0f * relb[0] - 43.0f;
        const bool c0 = (lane < t_hi) && (fn[64 * lane + 63] < lim), c1 = (lane + 64 < t_hi) && (fn[64 * (lane + 64) + 63] < lim);
        t_lo = ((int)__builtin_popcountll(__ballot(c0)) + (int)__builtin_popcountll(__ballot(c1))) & ~1;
        if (t_lo > t_hi - 4) t_lo = t_hi - 4; }
    t_lo = __builtin_amdgcn_readfirstlane(t_lo);
    const int NT = t_hi - t_lo;
    const bf16_t* Qw = Qp + (rowbase + q0 + wid * 32) * LD + h * 64;
    const bf16_t* Kh = Kp + (rowbase + (size_t)t_lo * 64) * LD + h * 64, *Vh = Vp + (rowbase + (size_t)t_lo * 64) * LD + h * 64;
    const unsigned lds0 = (unsigned)(size_t)lds;
    LAS float* wsf = (LAS float*)(lds + L_WS) + wid * 64;
    const bf16_t* ksrc = Kh + (size_t)lane * LD + wid * 8;
    const bf16_t* vsrc = Vh + (size_t)(16 * (wid & 3) + (lane >> 2)) * LD + (wid >> 2) * 32 + (lane & 3) * 8;
    const unsigned* asrc = (TYPE == T_C) ? aux + (size_t)(b * 5 + h) * SEQ + (size_t)t_lo * 64 + lane : aux + ((size_t)(b * 256 + qb * 8 + wid) * 128) * 64 + lane;
    const unsigned kdst = lds0 + L_K + wid * 1024, vdst = lds0 + L_V + wid * 1024, adst = lds0 + L_AUX + wid * 768;
#define DMA_K(t, slot) glds16(ksrc + (size_t)(t) * 64 * LD, (unsigned)__builtin_amdgcn_readfirstlane(kdst + (slot)))
#define DMA_V(t, slot) glds16(vsrc + (size_t)(t) * 64 * LD, (unsigned)__builtin_amdgcn_readfirstlane(vdst + (slot)))
#define DMA_A(t, slot) glds4(asrc + (size_t)(t) * 64, (unsigned)__builtin_amdgcn_readfirstlane(adst + ((slot) >> 5)))
    const int vb0 = (int)(lds0 + L_V) + ((lane >> 4) & 1) * 32 + (lane & 3) * 8 + (4 * hi + ((lane & 15) >> 2)) * 64;
    bf16x8 kf[8];
    const LAS unsigned char* kp0 = lds + L_K + hi * 1024 + r32 * 16;
    const LAS unsigned char* vp0 = lds + L_V + ((lane >> 4) & 1) * 32 + (lane & 3) * 8 + (4 * hi + ((lane & 15) >> 2)) * 64;
    const LAS unsigned char* auxw = lds + L_AUX + wid * 768;
    DMA_K(0, 0); DMA_A(0, 0); DMA_A(1, SLOTB); DMA_A(2, 2 * SLOTB); DMA_V(0, 0); DMA_K(1, SLOTB);
    bf16x8 qr[4];
#pragma unroll
    for (int d0 = 0; d0 < 4; ++d0) qr[d0] = *(const bf16x8*)(Qw + (size_t)r32 * LD + d0 * 16 + hi * 8);
    float mhat = -1024.f, l_reg = 0.f; f32x16 o[2]; o[0] = f32x16{}; o[1] = f32x16{};
    const int qrel = wid * 32 + r32;
    const float NINF = -__builtin_inff();
    bool resc = false;
#define CMASK(P0, P1, t) do { if (TYPE == T_C) { const int jb_ = (t) - (NT - 4); if (jb_ >= 0) cmask(P0, P1, jb_, qrel, hi); } } while (0)
#define RESC() do { if (resc) { asm volatile("s_waitcnt lgkmcnt(0)" ::: "memory"); \
        _Pragma("unroll") for (int d_ = 0; d_ < 2; ++d_) _Pragma("unroll") for (int r = 0; r < 16; ++r) o[d_][r] *= wsf[crow(r, hi)]; } } while (0)
#define MX3(a, b, c) __builtin_fmaxf(__builtin_fmaxf((a), (b)), (c))
#define DECIDE(C0, C1) do { float ma_ = MX3(C0[0], C0[1], C1[0]), mb_ = MX3(C0[2], C0[3], C1[1]); ma_ = MX3(ma_, C1[2], C1[3]); \
        _Pragma("unroll") for (int r = 4; r < 16; r += 4) { ma_ = MX3(ma_, C0[r], C0[r + 1]); mb_ = MX3(mb_, C0[r + 2], C0[r + 3]); ma_ = MX3(ma_, C1[r], C1[r + 1]); mb_ = MX3(mb_, C1[r + 2], C1[r + 3]); } \
        float rm_ = __builtin_fmaxf(ma_, mb_); { const u32x2 rr_ = __builtin_amdgcn_permlane32_swap(__float_as_uint(rm_), __float_as_uint(rm_), false, false); rm_ = __builtin_fmaxf(__uint_as_float(rr_[0]), __uint_as_float(rr_[1])); } \
        resc = false; \
        if (__builtin_expect(__any(rm_ > (float)THRL), 0)) { const float dl_ = __builtin_fmaxf(rm_, 0.f); mhat += dl_; \
            _Pragma("unroll") for (int r = 0; r < 16; ++r) { C0[r] -= dl_; C1[r] -= dl_; } \
            const float f_ = __builtin_amdgcn_exp2f(-dl_); l_reg *= f_; if (hi == 0) wsf[r32] = f_; resc = true; } } while (0)
#define BSEL4(P, i, w) do { P[4 * (i)] = att::bitsel<8 * (i)>(w, nref_, NINF); P[4 * (i) + 1] = att::bitsel<8 * (i) + 1>(w, nref_, NINF); P[4 * (i) + 2] = att::bitsel<8 * (i) + 2>(w, nref_, NINF); P[4 * (i) + 3] = att::bitsel<8 * (i) + 3>(w, nref_, NINF); } while (0)
#define BRD(P0, P1, AO, i) do { if (TYPE == T_C) { const f32x4 v_ = *(const LAS f32x4*)(auxw + (AO) + ((i) < 4 ? 0 : 128) + 32 * ((i) & 3) + 16 * hi); \
        if ((i) < 4) { P0[4 * ((i) & 3)] = v_[0]; P0[4 * ((i) & 3) + 1] = v_[1]; P0[4 * ((i) & 3) + 2] = v_[2]; P0[4 * ((i) & 3) + 3] = v_[3]; } \
        else { P1[4 * ((i) & 3)] = v_[0]; P1[4 * ((i) & 3) + 1] = v_[1]; P1[4 * ((i) & 3) + 2] = v_[2]; P1[4 * ((i) & 3) + 3] = v_[3]; } } } while (0)
#define BPC(P0, P1, i) do { if (TYPE == T_C) { \
            if ((i) < 4) { P0[4 * ((i) & 3)] -= mhat; P0[4 * ((i) & 3) + 1] -= mhat; P0[4 * ((i) & 3) + 2] -= mhat; P0[4 * ((i) & 3) + 3] -= mhat; } \
            else { P1[4 * ((i) & 3)] -= mhat; P1[4 * ((i) & 3) + 1] -= mhat; P1[4 * ((i) & 3) + 2] -= mhat; P1[4 * ((i) & 3) + 3] -= mhat; } } \
        else { if ((i) < 4) BSEL4(P0, (i) & 3, wn0); else BSEL4(P1, (i) & 3, wn1); } } while (0)
#define MASKW(AO) do { if (TYPE == T_A) { const u32x2 mq_ = *(const LAS u32x2*)(auxw + (AO) + r32 * 8); wn0 = mq_.x >> (4 * hi); wn1 = mq_.y >> (4 * hi); } } while (0)
#define BLD_ALL(P0, P1, AO) do { unsigned wn0 = 0, wn1 = 0; const float nref_ = -mhat; (void)nref_; MASKW(AO); \
        BRD(P0, P1, AO, 0); BRD(P0, P1, AO, 1); BRD(P0, P1, AO, 2); BRD(P0, P1, AO, 3); BRD(P0, P1, AO, 4); BRD(P0, P1, AO, 5); BRD(P0, P1, AO, 6); BRD(P0, P1, AO, 7); \
        BPC(P0, P1, 0); BPC(P0, P1, 1); BPC(P0, P1, 2); BPC(P0, P1, 3); BPC(P0, P1, 4); BPC(P0, P1, 5); BPC(P0, P1, 6); BPC(P0, P1, 7); } while (0)
    f32x16 pA0, pA1, pB0, pB1;
    int sl_prev = 0, sl_cur = 0, sl_next = SLOTB;
#define ROT() do { sl_prev = sl_cur; sl_cur = sl_next; sl_next = (sl_next == (NSLOT - 1) * SLOTB) ? 0 : sl_next + SLOTB; } while (0)
    DMA_K(2, 2 * SLOTB);
    WAIT_BAR(3);
    BLD_ALL(pA0, pA1, 0);
    { const LAS unsigned char* kb_ = lds + L_K + hi * 1024 + r32 * 16;
#pragma unroll
      for (int d0 = 0; d0 < 4; ++d0) { const bf16x8 b0 = *(const LAS bf16x8*)(kb_ + d0 * 2048), b1 = *(const LAS bf16x8*)(kb_ + d0 * 2048 + 512);
          pA0 = __builtin_amdgcn_mfma_f32_32x32x16_bf16(b0, qr[d0], pA0, 0, 0, 0); pA1 = __builtin_amdgcn_mfma_f32_32x32x16_bf16(b1, qr[d0], pA1, 0, 0, 0); } }
    asm volatile("s_nop 15\n\ts_nop 7" : "+v"(pA0), "+v"(pA1));
    CMASK(pA0, pA1, 0);
    DECIDE(pA0, pA1);
#pragma unroll
    for (int r = 0; r < 16; ++r) { pA0[r] = __builtin_amdgcn_exp2f(pA0[r]); pA1[r] = __builtin_amdgcn_exp2f(pA1[r]); }
    BLD_ALL(pB0, pB1, SLOTB >> 5);
    WAIT_BAR(0);
    DMA_K(3, 0); DMA_A(3, 0); DMA_V(1, SLOTB);
    ROT();
    kload8(kf, kp0 + sl_cur);
    WAIT_BAR(3);
    s16x4 vlo[8], vhi[8]; u32x4 pw0, pw1, pw2, pw3;
#define PKW(P, B) cvtpk(P[B], P[B + 1])
#define PAF(k) __builtin_bit_cast(bf16x8, pw##k)
#define VFR(i) (bf16x8){vlo[i][0], vlo[i][1], vlo[i][2], vlo[i][3], vhi[i][0], vhi[i][1], vhi[i][2], vhi[i][3]}
#define PIN(x) asm volatile("" : "+v"(x))
#define GAPA(MF, A0, A1, A2, A3, W0, W1, PW) do { MF; sacc += A0; sacc += A1; sacc += A2; sacc += A3; PIN(sacc); W0; W1; PIN(PW); SBAR(); } while (0)
#define EX(v) __builtin_amdgcn_exp2f(v)
#define GAPB(MF, X, B, EXTRA) do { MF; X[B] = EX(X[B]); X[B + 1] = EX(X[B + 1]); X[B + 2] = EX(X[B + 2]); X[B + 3] = EX(X[B + 3]); PIN(X); EXTRA; SBAR(); } while (0)
#define VRD(i) do { vlo[i] = att::vtr(vp_ + (((i) >> 2) * 4096 + ((i) & 3) * 1024)); vhi[i] = att::vtr(vp_ + (((i) >> 2) * 4096 + ((i) & 3) * 1024 + 512)); } while (0)
#define KRD(G, j) do { if (G) { kload2(kf, kp0 + sl_next, j); SBAR(); } } while (0)
#define MFMA __builtin_amdgcn_mfma_f32_32x32x16_bf16
#define STEP(C0, C1, P0, P1, t, GK, GV, GL) do { SBAR(); \
        const LAS unsigned char* vp_ = vp0 + sl_prev; \
        unsigned wn0 = 0, wn1 = 0; if (GL) MASKW(sl_next >> 5); \
        VRD(0); SBAR(); float sacc = (P0[0] + P0[1]); \
        GAPA(C0 = MFMA(kf[0], qr[0], C0, 0, 0, 0), P0[2], P0[3], P0[4], P0[5],     pw0[0] = PKW(P0, 0), pw0[1] = PKW(P0, 2), pw0); \
        VRD(4); SBAR(); GAPA(C1 = MFMA(kf[1], qr[0], C1, 0, 0, 0), P0[6], P0[7], P0[8], P0[9],     pw0[2] = PKW(P0, 4), pw0[3] = PKW(P0, 6), pw0); \
        VRD(1); SBAR(); GAPA(C0 = MFMA(kf[2], qr[1], C0, 0, 0, 0), P0[10], P0[11], P0[12], P0[13], pw1[0] = PKW(P0, 8), pw1[1] = PKW(P0, 10), pw1); \
        VRD(5); SBAR(); GAPA(C1 = MFMA(kf[3], qr[1], C1, 0, 0, 0), P0[14], P0[15], P1[0], P1[1],   pw1[2] = PKW(P0, 12), pw1[3] = PKW(P0, 14), pw1); \
        VRD(2); SBAR(); GAPA(C0 = MFMA(kf[4], qr[2], C0, 0, 0, 0), P1[2], P1[3], P1[4], P1[5],     pw2[0] = PKW(P1, 0), pw2[1] = PKW(P1, 2), pw2); \
        VRD(6); SBAR(); GAPA(C1 = MFMA(kf[5], qr[2], C1, 0, 0, 0), P1[6], P1[7], P1[8], P1[9],     pw2[2] = PKW(P1, 4), pw2[3] = PKW(P1, 6), pw2); \
        VRD(3); SBAR(); GAPA(C0 = MFMA(kf[6], qr[3], C0, 0, 0, 0), P1[10], P1[11], P1[12], P1[13], pw3[0] = PKW(P1, 8), pw3[1] = PKW(P1, 10), pw3); \
        VRD(7); SBAR(); GAPA(C1 = MFMA(kf[7], qr[3], C1, 0, 0, 0), P1[14], P1[15], 0.f, 0.f,       pw3[2] = PKW(P1, 12), pw3[3] = PKW(P1, 14), pw3); \
        l_reg += sacc; \
        if (GK) { DMA_K((t) + 3, sl_cur); DMA_A((t) + 3, sl_cur); } if (GV) { DMA_V((t) + 1, sl_next); } \
        CMASK(C0, C1, t); \
        DECIDE(C0, C1); \
        const float nref_ = -mhat; (void)nref_; \
        SBAR(); \
        GAPB(o[0] = MFMA(PAF(0), VFR(0), o[0], 0, 0, 0), C0, 0, if (GL) { BRD(P0, P1, sl_next >> 5, 0); BRD(P0, P1, sl_next >> 5, 1); BRD(P0, P1, sl_next >> 5, 2); BRD(P0, P1, sl_next >> 5, 3); if (TYPE == T_A) { BPC(P0, P1, 0); PIN(P0); } }); \
        GAPB(o[1] = MFMA(PAF(0), VFR(4), o[1], 0, 0, 0), C0, 4, if (GL) { BRD(P0, P1, sl_next >> 5, 4); BRD(P0, P1, sl_next >> 5, 5); BRD(P0, P1, sl_next >> 5, 6); BRD(P0, P1, sl_next >> 5, 7); if (TYPE == T_A) { BPC(P0, P1, 1); PIN(P0); } else { BPC(P0, P1, 0); PIN(P0); } }); \
        KRD(GL, 0); GAPB(o[0] = MFMA(PAF(1), VFR(1), o[0], 0, 0, 0), C0, 8,  if (GL) { if (TYPE == T_A) { BPC(P0, P1, 2); } else { BPC(P0, P1, 1); } PIN(P0); }); \
        KRD(GL, 1); GAPB(o[1] = MFMA(PAF(1), VFR(5), o[1], 0, 0, 0), C0, 12, if (GL) { if (TYPE == T_A) { BPC(P0, P1, 3); } else { BPC(P0, P1, 2); } PIN(P0); }); \
        KRD(GL, 2); GAPB(o[0] = MFMA(PAF(2), VFR(2), o[0], 0, 0, 0), C1, 0,  if (GL) { if (TYPE == T_A) { BPC(P0, P1, 4); PIN(P1); } else { BPC(P0, P1, 3); PIN(P0); } }); \
        KRD(GL, 3); GAPB(o[1] = MFMA(PAF(2), VFR(6), o[1], 0, 0, 0), C1, 4,  if (GL) { if (TYPE == T_A) { BPC(P0, P1, 5); } else { BPC(P0, P1, 4); } PIN(P1); }); \
        GAPB(o[0] = MFMA(PAF(3), VFR(3), o[0], 0, 0, 0), C1, 8,  if (GL) { if (TYPE == T_A) { BPC(P0, P1, 6); } else { BPC(P0, P1, 5); } PIN(P1); }); \
        GAPB(o[1] = MFMA(PAF(3), VFR(7), o[1], 0, 0, 0), C1, 12, if (GL) { if (TYPE == T_A) { BPC(P0, P1, 7); } else { BPC(P0, P1, 6); BPC(P0, P1, 7); } PIN(P1); }); \
    } while (0)
    int t = 1;
#undef CMASK
#define CMASK(P0, P1, t) do { } while (0)
    for (; t + 5 < NT; t += 2) {
        STEP(pB0, pB1, pA0, pA1, t, true, true, true);       WAIT_BAR(3); RESC(); ROT();
        STEP(pA0, pA1, pB0, pB1, t + 1, true, true, true);   WAIT_BAR(3); RESC(); ROT();
    }
#undef CMASK
#define CMASK(P0, P1, t) do { if (TYPE == T_C) { const int jb_ = (t) - (NT - 4); if (jb_ >= 0) cmask(P0, P1, jb_, qrel, hi); } } while (0)
#define ENDW(tt) do { if ((tt) + 3 < NT) { WAIT_BAR(3); } else if ((tt) + 2 < NT) { WAIT_BAR(1); } else { WAIT_BAR(0); } } while (0)
    for (; t + 1 < NT; t += 2) {
        STEP(pB0, pB1, pA0, pA1, t, (t + 3 < NT), (t + 1 < NT), (t + 1 < NT));       ENDW(t);     RESC(); ROT();
        STEP(pA0, pA1, pB0, pB1, t + 1, (t + 4 < NT), (t + 2 < NT), (t + 2 < NT));   ENDW(t + 1); RESC(); ROT();
    }
    STEP(pB0, pB1, pA0, pA1, NT - 1, false, false, false); RESC();
    { float sacc = pB0[0] + pB0[1];
#pragma unroll
      for (int r = 2; r < 16; ++r) sacc += pB0[r];
#pragma unroll
      for (int r = 0; r < 16; ++r) sacc += pB1[r];
      l_reg += sacc;
      pw0 = (u32x4){PKW(pB0, 0), PKW(pB0, 2), PKW(pB0, 4), PKW(pB0, 6)}; pw1 = (u32x4){PKW(pB0, 8), PKW(pB0, 10), PKW(pB0, 12), PKW(pB0, 14)};
      pw2 = (u32x4){PKW(pB1, 0), PKW(pB1, 2), PKW(pB1, 4), PKW(pB1, 6)}; pw3 = (u32x4){PKW(pB1, 8), PKW(pB1, 10), PKW(pB1, 12), PKW(pB1, 14)};
      SBAR(); pv(o, vb0 + sl_cur, PAF(0), PAF(1), PAF(2), PAF(3)); }
#undef PKW
#undef PAF
#undef VFR
#undef PIN
#undef GAPA
#undef GAPB
#undef EX
#undef VRD
#undef KRD
#undef STEP
#undef ENDW
#undef MFMA
    { const u32x2 rr = __builtin_amdgcn_permlane32_swap(__float_as_uint(l_reg), __float_as_uint(l_reg), false, false); l_reg = __uint_as_float(rr[0]) + __uint_as_float(rr[1]); }
    if (hi == 0) wsf[32 + r32] = l_reg;
    asm volatile("s_waitcnt lgkmcnt(0)" ::: "memory");
    LAS bf16_t* stg = (LAS bf16_t*)(lds + L_OST) + wid * 2048;
#pragma unroll
    for (int g4 = 0; g4 < 4; ++g4) { const f32x4 lv = *(const LAS f32x4*)(wsf + 32 + 8 * g4 + 4 * hi);
#pragma unroll
        for (int j = 0; j < 4; ++j) { const int r = 4 * g4 + j, orow = crow(r, hi); const float rl = __builtin_amdgcn_rcpf(lv[j]);
            stg[orow * 64 + r32] = (bf16_t)f2bf(o[0][r] * rl); stg[orow * 64 + 32 + r32] = (bf16_t)f2bf(o[1][r] * rl); } }
    asm volatile("s_waitcnt lgkmcnt(0)" ::: "memory");
    bf16_t* Ow = Op + (rowbase + q0 + wid * 32) * MIXW;
#pragma unroll
    for (int i = 0; i < 4; ++i) { const int row = i * 8 + (lane >> 3), ch = lane & 7; const u32x4 v = *(const LAS u32x4*)(stg + row * 64 + ch * 8); *(u32x4*)(Ow + (size_t)row * MIXW + ch * 8) = v; }
    if (TYPE != T_A) { if (h == 4) {
        bf16_t* Oz = Ow + 64;
#pragma unroll
        for (int i = 0; i < 4; ++i) { const int row = i * 8 + (lane >> 3), ch = lane & 7; *(u32x4*)(Oz + (size_t)row * MIXW + ch * 8) = (u32x4){0u, 0u, 0u, 0u}; } } }
    asm volatile("s_waitcnt lgkmcnt(0)\n\ts_barrier" ::: "memory");
#undef DMA_K
#undef DMA_V
#undef DMA_A
#undef CMASK
#undef RESC
#undef ROT
#undef MX3
#undef DECIDE
#undef BSEL4
#undef BRD
#undef BPC
#undef MASKW
#undef BLD_ALL
}
#undef SBAR
#undef WAIT_BAR
}

__device__ __forceinline__ void scan_unit(Frame& F, int bh) {
    const int b = bh / 5, h = bh % 5;
    const float* FC = (const float*)(F.ws + WS_FC); float* FCUM = (float*)(F.ws + WS_FCUM) + (size_t)bh * SEQ;
    LAS float* wt = (LAS float*)F.lds;
    const int t0 = F.tid * 16;
    float v[16]; float run = 0.f;
#pragma unroll
    for (int j = 0; j < 16; ++j) { run += FC[((size_t)b * SEQ + t0 + j) * 8 + h]; v[j] = run; }
    float inc = run;
#pragma unroll
    for (int o = 1; o < 64; o <<= 1) { const float y = lane_get_f(inc, (F.lane - o) & 63); if (F.lane >= o) inc += y; }
    if (F.lane == 63) wt[F.wave] = inc;
    __syncthreads();
    float base = inc - run;
    for (int w = 0; w < F.wave; ++w) base += wt[w];
#pragma unroll
    for (int j = 0; j < 16; ++j) FCUM[t0 + j] = -(base + v[j]) * LOG2E;
    const bf16_t* QC = (const bf16_t*)(F.ws + P_QC) + ((size_t)b * SEQ + t0) * 320 + h * 64; const bf16_t* KC = (const bf16_t*)(F.ws + P_KC) + ((size_t)b * SEQ + t0) * 320 + h * 64;
    float mq = 0.f, mk = 0.f;
    for (int j = 0; j < 16; ++j) { float sq = 0.f, sk = 0.f;
#pragma unroll
        for (int c8 = 0; c8 < 8; ++c8) { const u32x4 a = *(const u32x4*)(QC + (size_t)j * 320 + c8 * 8), k4 = *(const u32x4*)(KC + (size_t)j * 320 + c8 * 8);
#pragma unroll
            for (int e = 0; e < 4; ++e) { const float a0 = bf2f(a[e] & 0xffff), a1 = bf2f(a[e] >> 16), k0 = bf2f(k4[e] & 0xffff), k1 = bf2f(k4[e] >> 16); sq = fmaf(a0, a0, fmaf(a1, a1, sq)); sk = fmaf(k0, k0, fmaf(k1, k1, sk)); } }
        mq = fmaxf(mq, sq); mk = fmaxf(mk, sk); }
#pragma unroll
    for (int o = 1; o < 64; o <<= 1) { mq = fmaxf(mq, lane_get_f(mq, F.lane ^ o)); mk = fmaxf(mk, lane_get_f(mk, F.lane ^ o)); }
    if (F.lane == 0) { wt[16 + F.wave] = mq; wt[32 + F.wave] = mk; }
    __syncthreads();
    if (F.tid == 0) { float a = 0.f, c = 0.f; for (int w = 0; w < 8; ++w) { a = fmaxf(a, wt[16 + w]); c = fmaxf(c, wt[32 + w]); }
        ((float*)(F.ws + WS_SMAX))[bh] = sqrtf(a * c) * 1.01f; }
    __syncthreads();
}

namespace idx {
constexpr int L_HIST = 0, L_MASK = 32768, L_LVAL = 65536, L_LKEY = 73728, L_LCNT = 81920, L_ST = 82048, L_PAR = 82304, L_BQ = 82560, L_NEED = 82688, L_RES = 82816, L_FLAG = 82944, L_QF = 98304, L_END = L_QF + 32768;
static_assert(L_END <= RING_BYTES, "index LDS");
constexpr int LCAP = 64, MAXLEV = 8;

__device__ __forceinline__ void load_kf(bf16x8 (&kf)[4], const bf16_t* __restrict__ kr) {
#pragma unroll
    for (int ks = 0; ks < 4; ++ks) kf[ks] = *(const bf16x8*)(kr + ks * 16);
}
#define IDX_LDQ(dst, h) do { _Pragma("unroll") for (int ks_ = 0; ks_ < 4; ++ks_) dst[ks_] = *(const LAS bf16x8*)(qfl + ((h) * 4 + ks_) * 1024); } while (0)
#define IDX_MM(d, q) do { _Pragma("unroll") for (int ks_ = 0; ks_ < 4; ++ks_) d = __builtin_amdgcn_mfma_f32_32x32x16_bf16(kf[ks_], q[ks_], ks_ ? d : zero16, 0, 0, 0); } while (0)
#define IDX_ACC(d, wh) do { _Pragma("unroll") for (int r_ = 0; r_ < 16; ++r_) sc[r_] = fmaf(fabsf(d[r_]), wh, sc[r_]); } while (0)
__device__ __forceinline__ f32x16 score_tile(const bf16x8 (&kf)[4], const LAS unsigned char* qfl_, const bf16x8 (&ql)[4], const float (&w)[8]) {
    const LAS unsigned char* qfl = qfl_; asm volatile("" : "+v"(qfl));
    const f32x16 zero16 = {};
    bf16x8 qa[4], qb[4], qc[4]; f32x16 sc, da, db;
    IDX_LDQ(qa, 0); IDX_LDQ(qb, 1);
    IDX_MM(sc, ql);
    IDX_LDQ(qc, 2); IDX_MM(da, qa);
    IDX_LDQ(qa, 3); IDX_MM(db, qb); IDX_ACC(da, w[0]);
    IDX_LDQ(qb, 4); IDX_MM(da, qc); IDX_ACC(db, w[1]);
    IDX_LDQ(qc, 5); IDX_MM(db, qa); IDX_ACC(da, w[2]);
    IDX_LDQ(qa, 6); IDX_MM(da, qb); IDX_ACC(db, w[3]);
    IDX_LDQ(qb, 7); IDX_MM(db, qc); IDX_ACC(da, w[4]);
    IDX_MM(da, qa); IDX_ACC(db, w[5]);
    IDX_MM(db, qb); IDX_ACC(da, w[6]);
    IDX_ACC(db, w[7]);
    return sc;
}
__device__ __forceinline__ int bucket(float s, float scale, float off) { return (int)fminf(fmaxf(fmaf(s, scale, off), 0.f), 255.f); }

__device__ __forceinline__ void index_slow(LAS unsigned char* lds, const LAS unsigned char* qfl, const bf16x8 (&ql)[4], const float (&w)[8], const bf16_t* __restrict__ kbase, unsigned* mg,
                                           int nk32, int ntot, int tid, int lane, int r32, int hi, int wid) {
    LAS unsigned* HIST = (LAS unsigned*)(lds + L_HIST); LAS unsigned* MASK = (LAS unsigned*)(lds + L_MASK);
    LAS float* LVAL = (LAS float*)(lds + L_LVAL); LAS unsigned* LKEY = (LAS unsigned*)(lds + L_LKEY); LAS unsigned* LCNT = (LAS unsigned*)(lds + L_LCNT);
    LAS float* ST = (LAS float*)(lds + L_ST); LAS float* PAR = (LAS float*)(lds + L_PAR); LAS int* BQ = (LAS int*)(lds + L_BQ); LAS int* NEED = (LAS int*)(lds + L_NEED);
    LAS int* RES = (LAS int*)(lds + L_RES); LAS unsigned* FLAG = (LAS unsigned*)(lds + L_FLAG);
    if (tid < 64) ST[tid] = 0.f;
    if (tid < 32) RES[tid] = 0;
    if (tid == 0) FLAG[0] = 0u;
    __syncthreads();
    const int stride = (nk32 / 16) > 1 ? (nk32 / 16) : 1, ns = (nk32 + stride - 1) / stride;
    { float s1 = 0.f, s2 = 0.f;
      bf16x8 kf[4]; load_kf(kf, kbase + (size_t)((wid < ns ? wid : 0) * stride) * 32 * 64);
      for (int j = wid; j < ns; j += 8) { bf16x8 kn[4]; load_kf(kn, kbase + (size_t)((j + 8 < ns ? j + 8 : j) * stride) * 32 * 64);
          const f32x16 sc = score_tile(kf, qfl, ql, w);
#pragma unroll
          for (int ks = 0; ks < 4; ++ks) kf[ks] = kn[ks];
#pragma unroll
          for (int r = 0; r < 16; ++r) { s1 += sc[r]; s2 = fmaf(sc[r], sc[r], s2); } }
      __hip_atomic_fetch_add(ST + 2 * r32, s1, __ATOMIC_RELAXED, __HIP_MEMORY_SCOPE_WORKGROUP);
      __hip_atomic_fetch_add(ST + 2 * r32 + 1, s2, __ATOMIC_RELAXED, __HIP_MEMORY_SCOPE_WORKGROUP); }
    __syncthreads();
    if (tid < 32) { const float n = (float)(ns * 32), mean = ST[2 * tid] / n; float var = ST[2 * tid + 1] / n - mean * mean; var = var > 1e-20f ? var : 1e-20f;
        const float sd = sqrtf(var), lo = mean - 3.5f * sd; PAR[2 * tid] = lo; PAR[2 * tid + 1] = 254.0f / (10.0f * sd); }
    __syncthreads();
    for (int lev = 0; lev < MAXLEV; ++lev) {
        for (int i = tid; i < 2048; i += 512) ((LAS u32x4*)HIST)[i] = (u32x4){0u, 0u, 0u, 0u};
        __syncthreads();
        { const float scale = PAR[2 * r32 + 1], off = fmaf(-PAR[2 * r32], scale, 1.0f); const bool act = RES[r32] == 0;
          bf16x8 kf[4]; load_kf(kf, kbase + (size_t)wid * 32 * 64);
          for (int kt = wid; kt < nk32; kt += 8) { bf16x8 kn[4]; load_kf(kn, kbase + (size_t)(kt + 8 < nk32 ? kt + 8 : kt) * 32 * 64);
              const f32x16 sc = score_tile(kf, qfl, ql, w);
#pragma unroll
              for (int ks = 0; ks < 4; ++ks) kf[ks] = kn[ks];
              if (act) {
#pragma unroll
                  for (int r = 0; r < 16; ++r) __hip_atomic_fetch_add(HIST + r32 * 256 + bucket(sc[r], scale, off), 1u, __ATOMIC_RELAXED, __HIP_MEMORY_SCOPE_WORKGROUP); } } }
        __syncthreads();
        for (int qq = 0; qq < 4; ++qq) { const int q = wid * 4 + qq;
            if (RES[q] == 0) {
                const u32x4 hv = *(const LAS u32x4*)(HIST + q * 256 + 4 * lane);
                const unsigned sl = hv.x + hv.y + hv.z + hv.w; unsigned suf = sl;
#pragma nounroll
                for (int o = 1; o < 64; o <<= 1) { const unsigned y = lane_get_u(suf, (lane + o) & 63); if (lane + o < 64) suf += y; }
                const unsigned ge3 = suf - sl + hv.w, ge2 = ge3 + hv.z, ge1 = ge2 + hv.y, ge0 = ge1 + hv.x, above = suf - sl;
                int bq = -1; unsigned ab = 0, pop = 0;
                if (above < 256u && ge0 >= 256u) {
                    if (ge3 >= 256u) { bq = 4 * lane + 3; ab = above; pop = hv.w; }
                    else if (ge2 >= 256u) { bq = 4 * lane + 2; ab = ge3; pop = hv.z; }
                    else if (ge1 >= 256u) { bq = 4 * lane + 1; ab = ge2; pop = hv.y; }
                    else { bq = 4 * lane; ab = ge1; pop = hv.x; }
                    BQ[q] = bq; NEED[q] = 256 - (int)ab;
                    const float lo = PAR[2 * q], scale = PAR[2 * q + 1];
                    if (bq >= 1 && bq <= 254 && pop <= (unsigned)LCAP) RES[q] = 1;
                    else { if (bq == 255) { PAR[2 * q] = lo + 254.0f / scale; PAR[2 * q + 1] = scale * 0.0625f; }
                           else if (bq == 0) { PAR[2 * q + 1] = scale * 0.0625f; PAR[2 * q] = lo - 254.0f / (scale * 0.0625f); }
                           else { PAR[2 * q] = lo + (float)(bq - 1) / scale; PAR[2 * q + 1] = scale * 254.0f; }
                           __hip_atomic_fetch_add(FLAG, 1u, __ATOMIC_RELAXED, __HIP_MEMORY_SCOPE_WORKGROUP); }
                }
            }
        }
        __syncthreads();
        const unsigned unresolved = FLAG[0];
        __syncthreads();
        if (tid == 0) FLAG[0] = 0u;
        if (unresolved == 0u) break;
    }
    if (tid < 32) LCNT[tid] = 0u;
    __syncthreads();
    { const float scale = PAR[2 * r32 + 1], off = fmaf(-PAR[2 * r32], scale, 1.0f); const int bq = BQ[r32]; const bool res = RES[r32] != 0;
      bf16x8 kf[4]; load_kf(kf, kbase + (size_t)wid * 32 * 64);
      for (int kt = wid; kt < nk32; kt += 8) { bf16x8 kn[4]; load_kf(kn, kbase + (size_t)(kt + 8 < nk32 ? kt + 8 : kt) * 32 * 64);
          const f32x16 sc = score_tile(kf, qfl, ql, w);
#pragma unroll
          for (int ks = 0; ks < 4; ++ks) kf[ks] = kn[ks];
          unsigned bits = 0u;
#pragma unroll
          for (int r = 0; r < 16; ++r) { const int bk = bucket(sc[r], scale, off);
              const bool sel = (bk > bq) || (!res && bk == bq);
              bits |= (sel ? 1u : 0u) << ((r & 3) + 8 * (r >> 2));
              if (res && bk == bq) { const unsigned pos = __hip_atomic_fetch_add(LCNT + r32, 1u, __ATOMIC_RELAXED, __HIP_MEMORY_SCOPE_WORKGROUP);
                  if (pos < (unsigned)LCAP) { LVAL[r32 * LCAP + pos] = sc[r]; LKEY[r32 * LCAP + pos] = (unsigned)(kt * 32 + crow(r, hi)); } } }
          bits <<= 4 * hi;
          { const u32x2 rr = __builtin_amdgcn_permlane32_swap(bits, bits, false, false); bits = rr[0] | rr[1]; }
          if (hi == 0) MASK[kt * 32 + r32] = bits; } }
    __syncthreads();
    for (int qq = 0; qq < 4; ++qq) { const int q = wid * 4 + qq;
        if (RES[q] != 0) { const int n = (int)(LCNT[q] < (unsigned)LCAP ? LCNT[q] : (unsigned)LCAP), need = NEED[q];
            const float v = lane < n ? LVAL[q * LCAP + lane] : 0.f; const unsigned k = lane < n ? LKEY[q * LCAP + lane] : 0u;
            int rank = 0;
            for (int j = 0; j < n; ++j) { const float vj = LVAL[q * LCAP + j]; const unsigned kj = LKEY[q * LCAP + j]; rank += ((vj > v) || (vj == v && kj < k)) ? 1 : 0; }
            if (lane < n && rank < need) __hip_atomic_fetch_or(MASK + (k >> 5) * 32 + q, 1u << (k & 31), __ATOMIC_RELAXED, __HIP_MEMORY_SCOPE_WORKGROUP); } }
    __syncthreads();
    for (int i = tid; i < ntot * 32; i += 512) { const int t32 = 2 * (i >> 6) + (i & 1), q = (i >> 1) & 31; mg[i] = (t32 < nk32) ? MASK[t32 * 32 + q] : 0u; }
    __syncthreads();
}
__device__ __forceinline__ int hist_cross(const LAS unsigned* hrow, unsigned target, int lane, unsigned* above, unsigned* pop) {
    const u32x4 hv = *(const LAS u32x4*)(hrow + 4 * lane);
    const unsigned sl = hv.x + hv.y + hv.z + hv.w; unsigned suf = sl;
#pragma nounroll
    for (int o = 1; o < 64; o <<= 1) { const unsigned y = lane_get_u(suf, (lane + o) & 63); if (lane + o < 64) suf += y; }
    const unsigned ab = suf - sl, ge3 = ab + hv.w, ge2 = ge3 + hv.z, ge1 = ge2 + hv.y, ge0 = ge1 + hv.x;
    int bq = -1; unsigned a_ = 0, p_ = 0;
    if (ab < target && ge0 >= target) {
        if (ge3 >= target) { bq = 4 * lane + 3; a_ = ab; p_ = hv.w; }
        else if (ge2 >= target) { bq = 4 * lane + 2; a_ = ge3; p_ = hv.z; }
        else if (ge1 >= target) { bq = 4 * lane + 1; a_ = ge2; p_ = hv.y; }
        else { bq = 4 * lane; a_ = ge1; p_ = hv.x; }
    }
    const u64 m = __ballot(bq >= 0);
    if (m == 0ull) { *above = 0; *pop = 0; return -1; }
    const int src = (int)__builtin_ctzll(m);
    *above = lane_get_u(a_, src); *pop = lane_get_u(p_, src);
    return (int)lane_get_u((unsigned)bq, src);
}

constexpr int FCAP = 512, LF_VAL = 0, LF_KEY = 65536, LF_HIST = 0  ;
constexpr int LS_ST = RING_BYTES + 4096, LS_TW = LS_ST + 256, LS_CNT = LS_TW + 384, LS_LCNT = LS_CNT + 128, LS_FAIL = LS_LCNT + 128, LS_WH = RING_BYTES + 6144  ,
              LS_CV = LS_WH + 8192  , LS_END = LS_CV + 8 * 512;
static_assert(LF_KEY + 32 * FCAP * 2 <= L_QF && LS_END <= LDS_BYTES && L_END <= RING_BYTES, "index LDS");

__device__ __forceinline__ void index_unit(LAS unsigned char* lds, const bf16_t* __restrict__ QI, const bf16_t* __restrict__ KI, const float* __restrict__ WI, u64* maskT, int b, int qt, int tid_) {
    const int tid = launder_v(tid_), lane = tid & 63, r32 = lane & 31, hi = lane >> 5;
    const int wid = __builtin_amdgcn_readfirstlane(tid >> 6);
    const int c = qt >> 1, nk32 = 2 * (c + 1), ntot = 8 * ((qt >> 3) + 1);
    unsigned* mg = (unsigned*)(maskT + ((size_t)(b * 256 + qt) * 128) * 32);
    if (c <= 3) { for (int i = tid; i < ntot * 32; i += 512) { const int t32 = 2 * (i >> 6) + (i & 1); mg[i] = (t32 < nk32) ? 0xFFFFFFFFu : 0u; } return; }
    const size_t qrow = (size_t)b * SEQ + qt * 32 + r32;
    bf16x8 ql[4]; float w[8];
    { const f32x4 w0 = *(const f32x4*)(WI + qrow * 8), w1 = *(const f32x4*)(WI + qrow * 8 + 4);
      w[0] = w0[0]; w[1] = w0[1]; w[2] = w0[2]; w[3] = w0[3]; w[4] = w1[0]; w[5] = w1[1]; w[6] = w1[2]; w[7] = w1[3]; }
    const LAS unsigned char* qfl = lds + L_QF + hi * 512 + r32 * 16;
#pragma unroll
    for (int ks = 0; ks < 4; ++ks) *(LAS bf16x8*)(lds + L_QF + (wid * 4 + ks) * 1024 + hi * 512 + r32 * 16) = *(const bf16x8*)(QI + qrow * 512 + wid * 64 + ks * 16 + hi * 8);
    __syncthreads();
#pragma unroll
    for (int ks = 0; ks < 4; ++ks) { float a[8];
#pragma unroll
        for (int j = 0; j < 8; ++j) a[j] = 0.f;
#pragma unroll
        for (int h = 0; h < 8; ++h) { const bf16x8 qv = *(const LAS bf16x8*)(qfl + (h * 4 + ks) * 1024);
#pragma unroll
            for (int j = 0; j < 8; ++j) a[j] = fmaf(w[h], bf2f((unsigned short)qv[j]), a[j]); }
        u32x4 pk; pk.x = pk2(a[0], a[1]); pk.y = pk2(a[2], a[3]); pk.z = pk2(a[4], a[5]); pk.w = pk2(a[6], a[7]);
        ql[ks] = __builtin_bit_cast(bf16x8, pk); __builtin_amdgcn_sched_barrier(0); }
    const bf16_t* kbase = KI + ((size_t)b * SEQ + r32) * 64 + hi * 8;
    LAS float* ST = (LAS float*)(lds + LS_ST); LAS float* TW = (LAS float*)(lds + LS_TW);
    LAS unsigned* CNT = (LAS unsigned*)(lds + LS_CNT); LAS unsigned* LCNT = (LAS unsigned*)(lds + LS_LCNT); LAS unsigned* FAIL = (LAS unsigned*)(lds + LS_FAIL);
    LAS float* FVAL = (LAS float*)(lds + LF_VAL); LAS unsigned short* FKEY = (LAS unsigned short*)(lds + LF_KEY); LAS unsigned* SH = (LAS unsigned*)(lds + LF_HIST);
    if (tid < 64) ST[tid] = 0.f;
    if (tid < 32) { CNT[tid] = 0u; LCNT[tid] = 0u; }
    if (tid == 0) FAIL[0] = 0u;
    for (int i = tid; i < 2048; i += 512) ((LAS u32x4*)SH)[i] = (u32x4){0u, 0u, 0u, 0u};
    __syncthreads();
    { bf16x8 kf[4]; load_kf(kf, kbase + (size_t)((wid * nk32) >> 3) * 2048);
      const f32x16 sc = score_tile(kf, qfl, ql, w); float s1 = 0.f, s2 = 0.f;
#pragma unroll
      for (int r = 0; r < 16; ++r) { s1 += sc[r]; s2 = fmaf(sc[r], sc[r], s2); }
      __hip_atomic_fetch_add(ST + 2 * r32, s1, __ATOMIC_RELAXED, __HIP_MEMORY_SCOPE_WORKGROUP);
      __hip_atomic_fetch_add(ST + 2 * r32 + 1, s2, __ATOMIC_RELAXED, __HIP_MEMORY_SCOPE_WORKGROUP); }
    __syncthreads();
    const int ns = nk32 <= 64 ? nk32 : (nk32 >> 2);
    { const float mean = ST[2 * r32] * (1.0f / 256.0f); float var = ST[2 * r32 + 1] * (1.0f / 256.0f) - mean * mean; var = var > 1e-20f ? var : 1e-20f;
      const float sd = sqrtf(var), lo = mean - 4.0f * sd, scale = 254.0f / (11.0f * sd), off = fmaf(-lo, scale, 1.0f);
      if (wid == 0 && hi == 0) { TW[3 * r32] = lo; TW[3 * r32 + 2] = scale; }
      bf16x8 kf[4]; load_kf(kf, kbase + (size_t)(((wid < ns ? wid : 0) * nk32) / ns) * 2048);
      for (int j = wid; j < ns; j += 8) { bf16x8 kn[4]; load_kf(kn, kbase + (size_t)(((j + 8 < ns ? j + 8 : j) * nk32) / ns) * 2048);
          const f32x16 sc = score_tile(kf, qfl, ql, w);
#pragma unroll
          for (int ks = 0; ks < 4; ++ks) kf[ks] = kn[ks];
#pragma unroll
          for (int r = 0; r < 16; ++r) __hip_atomic_fetch_add(SH + r32 * 256 + bucket(sc[r], scale, off), 1u, __ATOMIC_RELAXED, __HIP_MEMORY_SCOPE_WORKGROUP); } }
    __syncthreads();
    for (int qq = 0; qq < 4; ++qq) { const int q = wid * 4 + qq;
        const unsigned ks_ = (256u * (unsigned)ns + (unsigned)nk32 - 1u) / (unsigned)nk32;
        const unsigned mrg = ns < nk32 ? (unsigned)(4.5f * sqrtf((float)ks_) + 1.0f) : 0u;
        const unsigned t_lo = ks_ + mrg, t_hi = ks_ > mrg + 1u ? ks_ - mrg : 1u;
        unsigned ab, pop; const int b1 = hist_cross(SH + q * 256, t_lo, lane, &ab, &pop); const int b2 = hist_cross(SH + q * 256, t_hi, lane, &ab, &pop);
        if (lane == 0) { const float lo = TW[3 * q], scale = TW[3 * q + 2];
            const float Tlo = b1 >= 1 ? lo + (float)(b1 - 1) / scale : -3.0e38f, Thi = b2 >= 254 ? 3.0e38f : lo + (float)(b2 < 0 ? 0 : b2) / scale;
            TW[3 * q] = Tlo; TW[3 * q + 1] = Thi; } }
    __syncthreads();
    { const float Tlo = TW[3 * r32], Thi = TW[3 * r32 + 1]; unsigned chi = 0u;
      bf16x8 kf[4]; load_kf(kf, kbase + (size_t)wid * 2048);
      for (int kt = wid; kt < nk32; kt += 8) { bf16x8 kn[4]; load_kf(kn, kbase + (size_t)(kt + 8 < nk32 ? kt + 8 : kt) * 2048);
          const f32x16 sc = score_tile(kf, qfl, ql, w);
#pragma unroll
          for (int ks = 0; ks < 4; ++ks) kf[ks] = kn[ks];
          unsigned bits = 0u; unsigned posq[16]; bool inw[16];
          constexpr int PD = 7;
#pragma unroll
          for (int r = 0; r < 16 + PD; ++r) {
              if (r < 16) { const float sv = sc[r]; const bool top = sv >= Thi;
                  bits |= (top ? 1u : 0u) << ((r & 3) + 8 * (r >> 2)); chi += top ? 1u : 0u;
                  inw[r] = sv >= Tlo && !top; posq[r] = 0u;
                  if (inw[r]) posq[r] = __hip_atomic_fetch_add(LCNT + r32, 1u, __ATOMIC_RELAXED, __HIP_MEMORY_SCOPE_WORKGROUP); }
              if (r >= PD) { const int s = r - PD;
                  if (inw[s] && posq[s] < (unsigned)FCAP) { FVAL[r32 * FCAP + posq[s]] = sc[s]; FKEY[r32 * FCAP + posq[s]] = (unsigned short)(kt * 32 + crow(s, hi)); } } }
          bits <<= 4 * hi;
          { const u32x2 rr = __builtin_amdgcn_permlane32_swap(bits, bits, false, false); bits = rr[0] | rr[1]; }
          if (hi == 0) mg[((kt >> 1) * 32 + r32) * 2 + (kt & 1)] = bits; }
      __hip_atomic_fetch_add(CNT + r32, chi, __ATOMIC_RELAXED, __HIP_MEMORY_SCOPE_WORKGROUP); }
    for (int i = nk32 * 32 + tid; i < ntot * 32; i += 512) { const int t32 = i >> 5, q = i & 31; mg[((t32 >> 1) * 32 + q) * 2 + (t32 & 1)] = 0u; }
    VM_WAIT(); __syncthreads();
    if (tid < 32) { const unsigned chi = CNT[tid], n = LCNT[tid]; if (chi > 256u || 256u - chi > n || n > (unsigned)FCAP) FAIL[0] = 1u; }
    __syncthreads();
    if (FAIL[0] != 0u) { index_slow(lds, qfl, ql, w, kbase, mg, nk32, ntot, tid, lane, r32, hi, wid); return; }
    LAS unsigned* WH = (LAS unsigned*)(lds + LS_WH) + wid * 256; LAS float* CVv = (LAS float*)(lds + LS_CV + wid * 512); LAS unsigned* CVk = (LAS unsigned*)(lds + LS_CV + wid * 512 + 256);
    for (int qq = 0; qq < 4; ++qq) { const int q = wid * 4 + qq;
        const int n = (int)LCNT[q], need = 256 - (int)CNT[q];
        if (need <= 0) continue;
        const LAS float* fv = FVAL + q * FCAP; const LAS unsigned short* fk = FKEY + q * FCAP;
        if (need < n) {
            float lo = TW[3 * q], span = TW[3 * q + 1] - lo; lo = lo > -1.0e38f ? lo : 0.f; span = span < 1.0e37f && span > 0.f ? span : 1.0f;
            float scale = 254.0f / span; int bq = 0; unsigned ab = 0, pop = 0;
            for (int lev = 0; lev < 6; ++lev) {
                *(LAS u32x4*)(WH + 4 * lane) = (u32x4){0u, 0u, 0u, 0u};
                const float off = fmaf(-lo, scale, 1.0f);
#pragma nounroll
                for (int i = lane; i < n; i += 64) __hip_atomic_fetch_add(WH + bucket(fv[i], scale, off), 1u, __ATOMIC_RELAXED, __HIP_MEMORY_SCOPE_WORKGROUP);
                LDS_WAIT();
                bq = hist_cross(WH, (unsigned)need, lane, &ab, &pop);
                if (pop <= 64u || lev == 5) break;
                lo = lo + (float)(bq - 1) / scale; scale = scale * 254.0f;
            }
            const float off = fmaf(-lo, scale, 1.0f);
            if (lane == 0) WH[0] = 0u;
            LDS_WAIT();
#pragma nounroll
            for (int i = lane; i < n; i += 64) { const float vi = fv[i]; if (bucket(vi, scale, off) == bq) { const unsigned pos = __hip_atomic_fetch_add(WH, 1u, __ATOMIC_RELAXED, __HIP_MEMORY_SCOPE_WORKGROUP);
                if (pos < 64u) { CVv[pos] = vi; CVk[pos] = (unsigned)fk[i]; } } }
            LDS_WAIT();
            const int nc = (int)(WH[0] < 64u ? WH[0] : 64u), take = need - (int)ab;
#pragma nounroll
            for (int i = lane; i < n; i += 64) { const float vi = fv[i]; const unsigned ki = (unsigned)fk[i]; const int bk = bucket(vi, scale, off); bool in = bk > bq;
                if (bk == bq) { int rank = 0; for (int j = 0; j < nc; ++j) { const float vj = CVv[j]; const unsigned kj = CVk[j]; rank += ((vj > vi) || (vj == vi && kj < ki)) ? 1 : 0; } in = rank < take; }
                if (in) atomicOr(mg + ((ki >> 6) * 32 + q) * 2 + ((ki >> 5) & 1), 1u << (ki & 31)); }
        } else {
#pragma nounroll
            for (int i = lane; i < n; i += 64) { const unsigned ki = (unsigned)fk[i]; atomicOr(mg + ((ki >> 6) * 32 + q) * 2 + ((ki >> 5) & 1), 1u << (ki & 31)); }
        }
    }
    VM_WAIT(); __syncthreads();
}
#undef IDX_LDQ
#undef IDX_MM
#undef IDX_ACC
}

constexpr int ARGTAB_OFF = RING_BYTES + 128;
__device__ __forceinline__ unsigned char* argp(LAS unsigned char* lds, int k) {
    const u32x2 v = *(volatile LAS u32x2*)(lds + ARGTAB_OFF + 8 * k);
    const unsigned lo = __builtin_amdgcn_readfirstlane(v.x), hi = __builtin_amdgcn_readfirstlane(v.y);
    return (unsigned char*)(GAS unsigned char*)(((u64)hi << 32) | lo);
}
#define ARG_IN(k) ((const void*)argp(LDSB, (k)))
#define ARG_OUT ((float*)argp(LDSB, 15))
#define ARG_WS (argp(LDSB, 16))
__device__ __forceinline__ int q_ask(unsigned* ctr, int tid) { int v = 0; if (tid == 0) v = (int)__hip_atomic_fetch_add(ctr, 1u, RLX_AGENT); return v; }
__device__ __forceinline__ int q_take(LAS unsigned char* lds, int v, int tid) {
    volatile LAS int* slot = (volatile LAS int*)(lds + RING_BYTES + 64);
    __syncthreads();
    if (tid == 0) *slot = v;
    __syncthreads();
    return *slot;
}

constexpr int PH_PRO = 0, PH_PER_LAYER = 10, PH_FINAL = 1 + DEPTH * PH_PER_LAYER, NPHASE = PH_FINAL + 1;
#ifndef REP_X
#define REP_X 1
#endif
#ifndef REP_Y
#define REP_Y 1
#endif
#ifndef REP_P1
#define REP_P1 1
#endif
#ifndef REP_F1
#define REP_F1 1
#endif
#ifndef REP_Z
#define REP_Z 1
#endif
#ifndef REP_N
#define REP_N 1
#endif
#ifndef REP2_X
#define REP2_X 7
#endif
#ifndef REP2_Y
#define REP2_Y 3
#endif
#ifndef REP_PRO
#define REP_PRO 1
#endif
#ifndef REP_G
#define REP_G 1
#endif
#ifndef ATT_DUMMY
#define ATT_DUMMY 0
#endif
#ifndef MK_ONE_LAUNCH
#define MK_ONE_LAUNCH 1
#endif

__global__ void __launch_bounds__(512, 2) fwd_kernel(Args args) {
    extern __shared__ __attribute__((aligned(16))) unsigned char lds_raw[];
    LAS unsigned char* const LDSB = (LAS unsigned char*)lds_raw;
    {
        const int tid0 = threadIdx.x;
        for (int u = tid0; u < (LDS_BYTES - RING_BYTES) / 4; u += 512) ((LAS unsigned*)(LDSB + RING_BYTES))[u] = 0u;
        __syncthreads();
        if (tid0 < 15) *(LAS u64*)(LDSB + ARGTAB_OFF + 8 * tid0) = (u64)args.in[tid0];
        if (tid0 == 15) *(LAS u64*)(LDSB + ARGTAB_OFF + 8 * 15) = (u64)args.out;
        if (tid0 == 16) *(LAS u64*)(LDSB + ARGTAB_OFF + 8 * 16) = (u64)args.ws;
        __syncthreads();
    }
    const int wave0 = __builtin_amdgcn_readfirstlane((int)threadIdx.x >> 6);
    if (MK_ONE_LAUNCH) (void)xcd_barrier_post((unsigned*)(ARG_WS + WS_CTL) + CW_BAR, (volatile LAS unsigned*)(LDSB + MISC_OFF) + 8, tid_from_wave(wave0));
#define GRID_BARRIER() do { XcdBarrier bar_; bar_.bar = (unsigned*)(ARG_WS + WS_CTL) + CW_BAR; bar_.x = xb_xcc_id(); bar_.st = (volatile LAS unsigned*)(LDSB + MISC_OFF) + 8; xcd_barrier(bar_, tid_from_wave(wave0)); } while (0)
    const int lo = args.ph_lo, hi = args.ph_hi;
#ifndef DBG_MASK
#define DBG_MASK 0xFFFF
#endif
#define IN(k) (lo <= (k) && (k) < hi)
#define EN(j) ((DBG_MASK >> (j)) & 1)
#define SEAM(k) do { if (MK_ONE_LAUNCH && IN((k) + 1)) GRID_BARRIER(); } while (0)
#define PH_FRAME unsigned char* ws = ARG_WS; Frame Fp; Fp.lds = LDSB; Fp.ws = ws; Fp.ctl = (unsigned*)(ws + WS_CTL); Fp.tid = tid_from_wave(wave0); Fp.lane = Fp.tid & 63; \
        Fp.wave = __builtin_amdgcn_readfirstlane(Fp.tid >> 6); Fp.G = launder_i(gridDim.x); Fp.bid = launder_i(blockIdx.x)
#define PH_LOCALS PH_FRAME; unsigned char* wl = ws + WS_W + (size_t)l * W_LAYER; const float* modl = (const float*)(ws + WS_MOD) + (size_t)l * 4 * 6144; const int bidl = Fp.bid, Gl = Fp.G; \
        float* xres = ARG_OUT; const float* xcur = (l == 0) ? (const float*)ARG_IN(0) : (const float*)xres; (void)wl; (void)modl; (void)bidl; (void)Gl; (void)xcur
    if (EN(10) && IN(PH_PRO)) { PH_FRAME;
        const void* ain[15];
#pragma unroll
        for (int i = 0; i < 15; ++i) ain[i] = ARG_IN(i);
        for (int rep = 0; rep < REP_PRO; ++rep) { phase_prologue(Fp, ain); if (rep + 1 < REP_PRO) GRID_BARRIER(); }
        SEAM(PH_PRO); }

#define LAYER_BODY(LL) { const int l = (LL); \
        const int pb = 1 + l * PH_PER_LAYER; \
        if (l == 0 && EN(0) && IN(pb + 0)) { PH_LOCALS; phase_first(Fp, xcur, (const float*)ARG_IN(5), (const float*)(ws + WS_MOD), nullptr); SEAM(pb + 0); } \
        if (EN(1) && IN(pb + 1)) { PH_LOCALS; \
            pg8::Gemm g{(const bf16_t*)(ws + WS_H), (const bf16_t*)(wl + W_P1), MTOK, NP1, DM, DM, DM, 0, 0}; pg8::StaticOrder S; S.init(MTOK, NP1, Gl, bidl); \
            pg8::EpiProj E{ws, (const float*)(ws + WS_CB) + (size_t)l * 4 * NCB1, (const float*)(ws + WS_SS) + (size_t)(2 * l) * MTOK, (const int*)ARG_IN(2)}; \
            for (int rep = 0; rep < REP_P1; ++rep) { pg8::gemm_phase<pg8::EpiProj>(Fp.lds, g, S, E, Fp.tid); if (rep + 1 < REP_P1) GRID_BARRIER(); } \
            SEAM(pb + 1); \
        } \
        if (EN(2) && IN(pb + 2)) { PH_LOCALS; \
            for (int rep = 0; rep < REP_X; ++rep) { \
            unsigned* ctr = (unsigned*)(ARG_WS + WS_CTL) + CW_Q + 64 * ((2 * l) * 4 + rep); \
            constexpr int N_SCAN = 20, N_IDX = 1024, N_B = 640; \
            const float* relb_l = (const float*)ARG_IN(8) + (size_t)l * 5 * 257; \
            for (int u = q_take(LDSB, q_ask(ctr, tid_from_wave(wave0)), tid_from_wave(wave0)); u < N_SCAN + N_IDX + N_B; ) { \
                unsigned char* ws = launder(Fp.ws); Frame Fu; Fu.lds = LDSB; Fu.ws = ws; Fu.ctl = (unsigned*)(ws + WS_CTL); Fu.tid = tid_from_wave(wave0); Fu.lane = Fu.tid & 63; Fu.wave = __builtin_amdgcn_readfirstlane(Fu.tid >> 6); Fu.G = 0; Fu.bid = 0; \
                const int xm = rep ? REP2_X : 7; \
                if (u < N_SCAN) { if (xm & 1) scan_unit(Fu, u); } \
                else if (u < N_SCAN + N_IDX) { if (xm & 2) { const int v = u - N_SCAN, qt = 255 - (v >> 2), b = v & 3; \
                    idx::index_unit(LDSB, (const bf16_t*)(ws + P_QI), (const bf16_t*)(ws + P_KI), (const float*)(ws + WS_WI), (u64*)(ws + WS_BM), b, qt, Fu.tid); } } \
                else if (xm & 4) { const int v = u - N_SCAN - N_IDX, qb = 31 - v / 20, rem = v % 20, b = rem / 5, h = rem % 5; \
                    att::attn_unit<att::ATT_B>(LDSB, (const bf16_t*)(ws + P_QB), (const bf16_t*)(ws + P_KB), (const bf16_t*)(ws + P_VB), 320, \
                        (bf16_t*)(ws + WS_MIX) + KBR + h * 64, b, h, qb, nullptr, relb_l + h * 257, Fu.tid); } \
                u = q_take(LDSB, q_ask(ctr, tid_from_wave(wave0)), tid_from_wave(wave0)); } \
            if (rep + 1 < REP_X) GRID_BARRIER(); } \
            SEAM(pb + 2); \
        } \
        if (EN(3) && IN(pb + 3)) { PH_LOCALS; \
            for (int rep = 0; rep < REP_Y; ++rep) { \
            unsigned* ctr = (unsigned*)(ARG_WS + WS_CTL) + CW_Q + 64 * ((2 * l + 1) * 4 + rep); \
            for (int u = q_take(LDSB, q_ask(ctr, tid_from_wave(wave0)), tid_from_wave(wave0)); u < 32 * 44; ) { \
                unsigned char* ws = launder(Fp.ws); const int tidu = tid_from_wave(wave0); \
                const int qb = 31 - u / 44, rem = u % 44; const int ym = rep ? REP2_Y : 3; \
                if (rem < 24) { if (ym & 1) { const int b = rem / 6, h = rem % 6; \
                    if (ATT_DUMMY && rep) att::attn_unit<att::ATT_A, ATT_DUMMY>(LDSB, (const bf16_t*)(ws + P_QA), (const bf16_t*)(ws + P_KA), (const bf16_t*)(ws + P_VA), 384, \
                        (bf16_t*)(ws + WS_MIX) + h * 64, b, h, qb, (const unsigned*)(ws + WS_BM), nullptr, tidu); \
                    else att2::attn_unit<att2::T_A, 384, 8>(LDSB, (const bf16_t*)(ws + P_QA), (const bf16_t*)(ws + P_KA), (const bf16_t*)(ws + P_VA), \
                        (bf16_t*)(ws + WS_MIX) + h * 64, b, h, qb, (const unsigned*)(ws + WS_BM), nullptr, tidu); } } \
                else if (ym & 2) { const int b = (rem - 24) / 5, h = (rem - 24) % 5; \
                    att2::attn_unit<att2::T_C, 320, 8>(LDSB, (const bf16_t*)(ws + P_QC), (const bf16_t*)(ws + P_KC), (const bf16_t*)(ws + P_VC), \
                        (bf16_t*)(ws + WS_MIX) + 2 * KBR + h * 64, b, h, qb, (const unsigned*)(ws + WS_FCUM), (const float*)(ws + WS_SMAX) + b * 5 + h, tidu); } \
                u = q_take(LDSB, q_ask(ctr, tid_from_wave(wave0)), tid_from_wave(wave0)); } \
            if (rep + 1 < REP_Y) GRID_BARRIER(); } \
            SEAM(pb + 3); \
        } \
        if (EN(4) && IN(pb + 4)) { PH_LOCALS; \
            pg8::Gemm g{(const bf16_t*)(ws + WS_MIX), (const bf16_t*)(wl + W_BR), MTOK, 3072, KBR, MIXW, KBR, 4, KBR * 2}; pg8::StaticOrder S; S.init(MTOK, 3072, Gl, bidl); \
            pg8::EpiPlain E{(bf16_t*)(ws + WS_P), 3072}; \
            for (int rep = 0; rep < REP_Z; ++rep) { pg8::gemm_phase<pg8::EpiPlain>(Fp.lds, g, S, E, Fp.tid); if (rep + 1 < REP_Z) GRID_BARRIER(); } \
            SEAM(pb + 4); \
        } \
        if (EN(5) && IN(pb + 5)) { PH_LOCALS; \
            pg8::Gemm g{(const bf16_t*)(ws + WS_H), (const bf16_t*)(wl + W_P2), MTOK, NP2, DM, DM, DM, 0, 0}; pg8::StaticOrder S; S.init(MTOK, NP2, Gl, bidl, 1); \
            pg8::EpiGate E{(const bf16_t*)(ws + WS_P), (bf16_t*)(ws + WS_Y), (const float*)(ws + WS_CB) + (size_t)l * 4 * NCB1 + NP1, (const float*)(ws + WS_SS) + (size_t)(2 * l) * MTOK}; \
            for (int rep = 0; rep < REP_G; ++rep) { pg8::gemm_phase<pg8::EpiGate>(Fp.lds, g, S, E, Fp.tid); if (rep + 1 < REP_G) GRID_BARRIER(); } \
            SEAM(pb + 5); \
        } \
        if (EN(6) && IN(pb + 6)) { PH_LOCALS; \
            pg8::Gemm g{(const bf16_t*)(ws + WS_Y), (const bf16_t*)(wl + W_OUT), MTOK, DM, DM, DM, DM, 0, 0}; pg8::StaticOrder S; S.init(MTOK, DM, Gl, bidl); \
            if (l == 0) { pg8::EpiRes<false, true> E{ARG_IN(0), (void*)xres, modl + 2048, (bf16_t*)(ws + WS_H), (const float*)ARG_IN(11) + l * DM, modl + 4096, (float*)(ws + WS_SS) + (size_t)(2 * l + 1) * MTOK}; \
                pg8::gemm_phase<pg8::EpiRes<false, true>>(Fp.lds, g, S, E, Fp.tid); } \
            else { pg8::EpiRes<true, true> E{(const void*)((const bf16_t*)xres + (size_t)MTOK * DM), (void*)(ws + WS_MIX), modl + 2048, (bf16_t*)(ws + WS_H), (const float*)ARG_IN(11) + l * DM, modl + 4096, (float*)(ws + WS_SS) + (size_t)(2 * l + 1) * MTOK}; \
                pg8::gemm_phase<pg8::EpiRes<true, true>>(Fp.lds, g, S, E, Fp.tid); } \
            SEAM(pb + 6); \
        } \
        if (EN(8) && IN(pb + 8)) { PH_LOCALS; \
            pg8::Gemm g{(const bf16_t*)(ws + WS_H), (const bf16_t*)(wl + W_F1), MTOK, 2 * FFH, DM, DM, DM, 0, 0}; pg8::StaticOrder S; S.init(MTOK, 2 * FFH, Gl, bidl); \
            pg8::EpiSwiGLU E{(bf16_t*)(ws + WS_P), (const float*)(ws + WS_CB) + CB2_OFF + (size_t)l * 4 * NCB2, (const float*)(ws + WS_SS) + (size_t)(2 * l + 1) * MTOK}; \
            for (int rep = 0; rep < REP_F1; ++rep) { pg8::gemm_phase<pg8::EpiSwiGLU>(Fp.lds, g, S, E, Fp.tid); if (rep + 1 < REP_F1) GRID_BARRIER(); } \
            SEAM(pb + 8); \
        } \
        if (EN(9) && IN(pb + 9)) { PH_LOCALS; \
            pg8::Gemm g{(const bf16_t*)(ws + WS_P), (const bf16_t*)(wl + W_F2), MTOK, DM, FFH, FFH, FFH, 0, 0}; pg8::StaticOrder S; S.init(MTOK, DM, Gl, bidl); \
            if (l + 1 < DEPTH) { pg8::EpiRes<true, true> E{(const void*)xres, (void*)((bf16_t*)xres + (size_t)MTOK * DM), modl + 5120, (bf16_t*)(ws + WS_H), (const float*)ARG_IN(5) + (l + 1 < DEPTH ? l + 1 : 0) * DM, \
                (const float*)(ws + WS_MOD) + (size_t)(l + 1 < DEPTH ? l + 1 : 0) * 4 * 6144 + 1024, (float*)(ws + WS_SS) + (size_t)(2 * (l + 1 < DEPTH ? l + 1 : 0)) * MTOK}; \
                pg8::gemm_phase<pg8::EpiRes<true, true>>(Fp.lds, g, S, E, Fp.tid); } \
            else { pg8::EpiRes<true, true> E{(const void*)(ws + WS_MIX), (void*)(ws + WS_Y), modl + 5120, (bf16_t*)nullptr, (const float*)ARG_IN(5), (const float*)(ws + WS_MOD) + 1024, (float*)(ws + WS_SSF)}; \
                pg8::gemm_phase<pg8::EpiRes<true, true>>(Fp.lds, g, S, E, Fp.tid); } \
            SEAM(pb + 9); \
        } \
    }
    LAYER_BODY(0)
    LAYER_BODY(1)
#undef LAYER_BODY
    if (EN(11) && IN(PH_FINAL)) { PH_FRAME; phase_final_norm(Fp, ARG_OUT, (const float*)ARG_IN(14)); }
#undef IN
#undef SEAM
}

extern "C" void kernel_launch(void* const* d_in, const int* in_sizes, int n_in, void* d_out, int out_size, void* d_ws, size_t ws_size, hipStream_t stream) {
    static int grid = 0;
    if (grid == 0) {
        if (n_in != 15 || out_size != MTOK * DM || ws_size < WS_END) { fprintf(stderr, "kernel_launch: unexpected problem (n_in %d out %d ws %zu)\n", n_in, out_size, ws_size); grid = -1; return; }
        int dev = 0, cus = 0, per_cu = 0;
        if (hipGetDevice(&dev) != hipSuccess || hipDeviceGetAttribute(&cus, hipDeviceAttributeMultiprocessorCount, dev) != hipSuccess) { grid = -1; return; }
        if (hipFuncSetAttribute((const void*)fwd_kernel, hipFuncAttributeMaxDynamicSharedMemorySize, LDS_BYTES) != hipSuccess) { fprintf(stderr, "kernel_launch: hipFuncSetAttribute failed\n"); grid = -1; return; }
        if (hipOccupancyMaxActiveBlocksPerMultiprocessor(&per_cu, (const void*)fwd_kernel, 512, LDS_BYTES) != hipSuccess || per_cu < 1) fprintf(stderr, "kernel_launch: occupancy query says %d\n", per_cu);
        (void)hipGetLastError();
        grid = cus;
    }
    if (grid < 0) return;
    (void)hipMemsetAsync((char*)d_ws + WS_CTL, 0, CTL_ZERO_BYTES, stream);
    Args a{};
    for (int i = 0; i < 15; ++i) a.in[i] = d_in[i];
    a.out = (float*)d_out; a.ws = (unsigned char*)d_ws;
#if MK_ONE_LAUNCH
    a.ph_lo = 0; a.ph_hi = NPHASE;
    hipLaunchKernelGGL(fwd_kernel, dim3(grid), dim3(512), LDS_BYTES, stream, a);
#else
    for (int p = 0; p < NPHASE; ++p) { a.ph_lo = p; a.ph_hi = p + 1; hipLaunchKernelGGL(fwd_kernel, dim3(grid), dim3(512), LDS_BYTES, stream, a); }
#endif
}
```

```cpp
#include <hip/hip_runtime.h>
#include <cstdio>
#include <cstdint>
#include <cmath>

#define GAS __attribute__((address_space(1)))
#define LAS __attribute__((address_space(3)))
#define CAS __attribute__((address_space(4)))
typedef unsigned short bf16_t;
typedef short bf16x8 __attribute__((ext_vector_type(8)));
typedef short s16x4 __attribute__((ext_vector_type(4)));
typedef float f32x4 __attribute__((ext_vector_type(4)));
typedef float f32x2 __attribute__((ext_vector_type(2)));
typedef float f32x16 __attribute__((ext_vector_type(16)));
typedef unsigned u32x4 __attribute__((ext_vector_type(4)));
typedef unsigned u32x2 __attribute__((ext_vector_type(2)));
typedef unsigned long long u64;

constexpr int NB = 4, SEQ = 8192, DM = 1024, MTOK = NB * SEQ, DEPTH = 2;
constexpr int IN_W = 6733, FFH = 2816, NP1 = 3840, NP2 = 3072, KBR = 384, MIXW = 3 * KBR;
constexpr int SRC_QA = 0, SRC_KA = 384, SRC_VA = 768, SRC_QI = 1152, SRC_KI = 1664, SRC_WI = 1728, SRC_B = 1736, SRC_C = 2696, SRC_F = 3656, SRC_G = 3661;
constexpr float LOG2E = 1.4426950408889634f;
constexpr float QSCALE = 0.125f * LOG2E;
constexpr float WI_SCALE = 0.5f * 0.35355339059327373f * 0.125f;
constexpr float RMS_EPS = 1e-6f;

constexpr size_t MiB = 1u << 20;
constexpr size_t WS_CTL = 0, CTL_ZERO_BYTES = 1 * MiB;
constexpr size_t WS_MOD = 1 * MiB;
constexpr size_t WS_BP1 = WS_MOD + 256 * 1024;
constexpr size_t WS_BP2 = WS_BP1 + 64 * 1024;
constexpr size_t WS_COS = 2 * MiB, WS_SIN = 3 * MiB;
constexpr size_t WS_WI = 4 * MiB, WS_FC = 5 * MiB;
constexpr size_t WS_FCUM = 6 * MiB;
constexpr size_t WS_SMAX = WS_FCUM + 768 * 1024;
constexpr size_t WS_SSF = 6 * MiB + 832 * 1024;
constexpr size_t WS_SS = 7 * MiB;
constexpr size_t WS_CB = WS_SS + 512 * 1024;
constexpr int NCB1 = NP1 + NP2, NCB2 = 2 * FFH;
constexpr size_t CB2_OFF = (size_t)DEPTH * 4 * NCB1;
static_assert(WS_CB + (CB2_OFF + (size_t)DEPTH * 4 * NCB2) * 4 <= 8 * MiB, "cb");
constexpr size_t WS_W = 8 * MiB, W_LAYER = 40 * MiB;
constexpr size_t W_P1 = 0, W_P2 = W_P1 + (size_t)NP1 * DM * 2, W_BR = W_P2 + (size_t)NP2 * DM * 2, W_OUT = W_BR + (size_t)3072 * KBR * 2,
                 W_F1 = W_OUT + (size_t)DM * 3072 * 2, W_F2 = W_F1 + (size_t)2 * FFH * DM * 2, W_END = W_F2 + (size_t)DM * FFH * 2;
static_assert(W_END <= W_LAYER, "weights");
constexpr size_t WS_H = 88 * MiB;
constexpr size_t WS_P = 152 * MiB;
constexpr size_t P_QA = WS_P, P_KA = P_QA + 24 * MiB, P_VA = P_KA + 24 * MiB, P_QI = P_VA + 24 * MiB, P_KI = P_QI + 32 * MiB,
                 P_QB = P_KI + 4 * MiB, P_KB = P_QB + 20 * MiB, P_VB = P_KB + 20 * MiB, P_QC = P_VB + 20 * MiB, P_KC = P_QC + 20 * MiB, P_VC = P_KC + 20 * MiB, P_END = P_VC + 20 * MiB;
constexpr size_t WS_Y = 344 * MiB;
constexpr size_t WS_BM = 384 * MiB;
constexpr size_t WS_MIX = 416 * MiB;
constexpr size_t WS_END = 488 * MiB;
static_assert(P_END <= WS_BM && WS_MIX + (size_t)MTOK * MIXW * 2 <= WS_END && WS_P + (size_t)MTOK * 3072 * 2 <= WS_Y && WS_Y + (size_t)MTOK * DM * 2 <= WS_MIX, "ws map");
constexpr int CW_Q = 64;
constexpr int CW_BAR = 4096;

constexpr int RING_BYTES = 131072, MISC_OFF = RING_BYTES + 320, LDS_BYTES = 155648;

#define RLX_AGENT __ATOMIC_RELAXED, __HIP_MEMORY_SCOPE_AGENT
#define LDS_WAIT() asm volatile("s_waitcnt lgkmcnt(0)" ::: "memory")
#define VM_WAIT() asm volatile("s_waitcnt vmcnt(0)" ::: "memory")
__device__ __forceinline__ unsigned f2bf(float f) { unsigned u = __builtin_bit_cast(unsigned, f); return (u + 0x7fffu + ((u >> 16) & 1u)) >> 16; }
__device__ __forceinline__ unsigned pk2(float lo, float hi) { return f2bf(lo) | (f2bf(hi) << 16); }
__device__ __forceinline__ float bf2f(unsigned short b) { return __builtin_bit_cast(float, ((unsigned)b) << 16); }
typedef __bf16 bf16x2_t __attribute__((ext_vector_type(2)));
__device__ __forceinline__ unsigned cvtpk(float lo, float hi) { f32x2 v = {lo, hi}; bf16x2_t b = __builtin_convertvector(v, bf16x2_t); return __builtin_bit_cast(unsigned, b); }
__device__ __forceinline__ float lane_get_f(float v, int src_lane) { return __builtin_bit_cast(float, __builtin_amdgcn_ds_bpermute(src_lane << 2, __builtin_bit_cast(int, v))); }
__device__ __forceinline__ unsigned lane_get_u(unsigned v, int src_lane) { return (unsigned)__builtin_amdgcn_ds_bpermute(src_lane << 2, (int)v); }
__device__ __forceinline__ float wave_sum(float v, int lane) {
#pragma unroll
    for (int o = 1; o < 64; o <<= 1) v += lane_get_f(v, lane ^ o);
    return v;
}
template <class T> __device__ __forceinline__ T* launder(T* p) { GAS T* g = (GAS T*)p; asm volatile("" : "+s"(g)); return (T*)g; }
__device__ __forceinline__ int launder_v(int v) { asm volatile("" : "+v"(v)); return v; }
__device__ __forceinline__ int launder_i(int v) { asm volatile("" : "+s"(v)); return v; }
__device__ __forceinline__ int tid_from_wave(int wave) { const unsigned m = (unsigned)launder_i(-1); return launder_i(wave) * 64 + (int)__builtin_amdgcn_mbcnt_hi(m, __builtin_amdgcn_mbcnt_lo(m, 0u)); }
__device__ __forceinline__ int crow(int r, int hi) { return (r & 3) + 8 * (r >> 2) + 4 * hi; }

#define XB_TMO      128
#define XB_XCNT(j)  (256  + 64 * (j))
#define XB_XSUB(j)  (1280 + 64 * (j))
#define XB_XGEN(j)  (2304 + 64 * (j))
#define XB_TOP      3328
#define XB_TOPGEN   3392
#define XCD_BAR_WORDS 3456
#define XB_SPIN_CAP (1u << 22)
__device__ __forceinline__ unsigned xb_ld(unsigned* p)              { return __hip_atomic_load(p, __ATOMIC_RELAXED, __HIP_MEMORY_SCOPE_AGENT); }
__device__ __forceinline__ unsigned xb_add(unsigned* p, unsigned v) { return __hip_atomic_fetch_add(p, v, __ATOMIC_RELAXED, __HIP_MEMORY_SCOPE_AGENT); }
__device__ __forceinline__ unsigned xb_xcc_id() { return (unsigned)__builtin_amdgcn_s_getreg((3 << 11) | 20) & 0xFu; }
#define XB_SPIN(cond, bar) do { unsigned _sp = 0; while (cond) { __builtin_amdgcn_s_sleep(1); \
    if ((++_sp & 255u) == 0u) { if (xb_ld(&(bar)[XB_TMO])) break; if (_sp > XB_SPIN_CAP) { atomicAdd(&(bar)[XB_TMO], 1u); break; } } } } while (0)
struct XcdBarrier { unsigned* bar; unsigned x; volatile LAS unsigned* st; };
__device__ __forceinline__ XcdBarrier xcd_barrier_post(unsigned* bar, volatile LAS unsigned* st, int tid) {
    XcdBarrier b; b.bar = bar; b.x = xb_xcc_id(); b.st = st;
    if (tid == 0) (void)xb_add(&bar[XB_XCNT(b.x)], 1u);
    return b;
}
__device__ __forceinline__ void xcd_barrier_complete(unsigned* bar, unsigned x, unsigned& nloc, unsigned& nx) {
    const unsigned G = gridDim.x * gridDim.y * gridDim.z;
    unsigned sum, cnt, mine, sp = 0u;
    for (;;) {
        sum = 0u; cnt = 0u; mine = 0u;
#pragma unroll
        for (unsigned j = 0; j < 16; ++j) { const unsigned c = xb_ld(&bar[XB_XCNT(j)]); sum += c; cnt += (c > 0u) ? 1u : 0u; mine = (j == x) ? c : mine; }
        if (sum == G) break;
        __builtin_amdgcn_s_sleep(1);
        if ((++sp & 255u) == 0u) { if (xb_ld(&bar[XB_TMO])) break; if (sp > XB_SPIN_CAP) { atomicAdd(&bar[XB_TMO], 1u); break; } }
    }
    nloc = mine > 0u ? mine : 1u; nx = cnt > 0u ? cnt : 1u;
}
__device__ __forceinline__ void xcd_barrier(const XcdBarrier& b, int tid) {
    asm volatile("s_waitcnt vmcnt(0)" ::: "memory");
    __syncthreads();
    if (tid == 0) {
        unsigned* bar = b.bar;
        __builtin_amdgcn_s_waitcnt(0);
        unsigned nloc = b.st[0], nx = b.st[1];
        if (nloc == 0u) { xcd_barrier_complete(bar, b.x, nloc, nx); b.st[0] = nloc; b.st[1] = nx; }
        const unsigned old = xb_add(&bar[XB_XSUB(b.x)], 1u);
        const unsigned gen = old / nloc;
        if (old + 1u == (gen + 1u) * nloc) {
            __builtin_amdgcn_fence(__ATOMIC_RELEASE, "agent");
            asm volatile("s_waitcnt vmcnt(0)" ::: "memory");
            const unsigned og = xb_add(&bar[XB_TOP], 1u);
            const unsigned tg = og / nx;
            if (og + 1u == (tg + 1u) * nx) xb_add(&bar[XB_TOPGEN], 1u);
            else XB_SPIN(xb_ld(&bar[XB_TOPGEN]) == tg, bar);
            __builtin_amdgcn_fence(__ATOMIC_ACQUIRE, "agent");
            xb_add(&bar[XB_XGEN(b.x)], 1u);
            asm volatile("s_waitcnt vmcnt(0)" ::: "memory");
        } else {
            XB_SPIN(xb_ld(&bar[XB_XGEN(b.x)]) == gen, bar);
            __builtin_amdgcn_fence(__ATOMIC_ACQUIRE, "agent");
            asm volatile("s_waitcnt vmcnt(0)" ::: "memory");
        }
    }
    __syncthreads();
}

namespace pg8 {
constexpr int BM = 256, BK = 64, HALF = 128, HTB = HALF * BK * 2, STAGE_BYTES = 8 * HTB, NXCD = 8, WGM = 8;
__host__ __device__ __forceinline__ int lds_byte(int r, int c) { const int st = (r >> 4) * 2 + (c >> 5), rr = r & 15, cc = c & 31, ob = rr * 64 + cc * 2; return st * 1024 + (ob ^ (((ob >> 9) & 1) << 5)); }
__host__ __device__ __forceinline__ void stage_rc(int b, int& R, int& C) { const int st = b / 1024, sb = b % 1024, swz = sb ^ (((sb >> 9) & 1) << 5); R = (st >> 1) * 16 + swz / 64; C = (st & 1) * 32 + (swz % 64) / 2; }
__host__ __device__ __forceinline__ int perm32(int rho) { const int n = rho >> 4, i = rho & 15; return 8 * (i >> 2) + 4 * n + (i & 3); }
struct Unit { int pm, pn; };
struct Gemm { const bf16_t* A; const bf16_t* Bt; int M, N, K, lda, ldb, agt, ags; };
struct StaticOrder {
    int nM, nN, nwg, G, c, trip;
    __host__ __device__ __forceinline__ void init(int M, int N, int G_, int c_, int trip_ = 0) { nM = M / BM; nN = N / BM; trip = trip_; if (trip) nN /= 3; nwg = nM * nN; G = G_; c = c_; }
    __host__ __device__ __forceinline__ bool next(int i, Unit& u) const {
        if (trip) { const int br = i % 3; if (!next1(i / 3, u)) return false; u.pn = 3 * u.pn + br; return true; }
        return next1(i, u);
    }
    __host__ __device__ __forceinline__ bool next1(int i, Unit& u) const {
        const long L = (long)i * G + c; if (L >= nwg) return false;
        int wgid = (int)L; { const int q = nwg / NXCD, r = nwg % NXCD, xcd = wgid % NXCD, off = wgid / NXCD; wgid = (xcd < r ? xcd * (q + 1) : r * (q + 1) + (xcd - r) * q) + off; }
        const int nig = WGM * nN, gid = wgid / nig, fm = gid * WGM, gsz = (nM - fm) < WGM ? (nM - fm) : WGM;
        u.pm = fm + ((wgid % nig) % gsz); u.pn = (wgid % nig) / gsz; return true;
    }
};

#ifndef GEMM_INL
#define GEMM_INL __forceinline__
#endif
template <class Epi>
__device__ GEMM_INL void gemm_phase(LAS unsigned char* lds, const Gemm g, const StaticOrder& S, const Epi& E, int tid_) {
    const int tid = launder_v(tid_), wid = __builtin_amdgcn_readfirstlane(tid >> 6), lane = tid & 63, wr = wid >> 2, wc = wid & 3, fr = lane & 15, fq = lane >> 4;
    int Kop = g.K; asm volatile("" : "+s"(Kop));
    const int nt = Kop / BK;
    unsigned voffA[2], voffB[2];
#pragma unroll
    for (int i = 0; i < 2; ++i) { int R, C; stage_rc(tid * 16 + i * 8192, R, C); const int Rb = Epi::PERM ? ((R & ~31) + perm32(R & 31)) : R;
        voffA[i] = (unsigned)(R * g.lda + C) * 2u; voffB[i] = (unsigned)(Rb * g.ldb + C) * 2u; }
    const size_t kstep = (size_t)(BK * 2);
    const size_t hstepA = (size_t)HALF * g.lda * 2, hstepB = (size_t)HALF * g.ldb * 2;
    const size_t tstepA = 2 * hstepA, tstepB = 2 * hstepB;
    const unsigned ldsw = (unsigned)wid * 1024u;
    const int aoff = lds_byte(wr * 64 + fr, fq * 8), boff = lds_byte(wc * 32 + fr, fq * 8);
#define PG8_SA(b, h) (((b) * 2 + (h)) * HTB)
#define PG8_SB(b, h) ((4 + (b) * 2 + (h)) * HTB)
#define PG8_STAGE(bufoff, gbase, voff) do { _Pragma("unroll") for (int _i = 0; _i < 2; ++_i) \
        __builtin_amdgcn_global_load_lds((const unsigned*)((const char*)(gbase) + (voff)[_i]), (LAS unsigned*)(lds + (bufoff) + ldsw + _i * 8192), 16, 0, 0); } while (0)
#define PG8_LDA(dst, b, h) do { _Pragma("unroll") for (int m = 0; m < 4; ++m) _Pragma("unroll") for (int k = 0; k < 2; ++k) dst[m][k] = *(const LAS bf16x8*)(lds + PG8_SA(b, h) + aoff + m * 2048 + k * 1024); } while (0)
#define PG8_LDB(dst, b, h) do { _Pragma("unroll") for (int n = 0; n < 2; ++n) _Pragma("unroll") for (int k = 0; k < 2; ++k) dst[n][k] = *(const LAS bf16x8*)(lds + PG8_SB(b, h) + boff + n * 2048 + k * 1024); } while (0)
#define PG8_MMA(ai, bj, At, Bt) do { __builtin_amdgcn_s_setprio(1); _Pragma("unroll") for (int m = 0; m < 4; ++m) _Pragma("unroll") for (int n = 0; n < 2; ++n) _Pragma("unroll") for (int k = 0; k < 2; ++k) \
        acc[ai][bj][m][n] = __builtin_amdgcn_mfma_f32_16x16x32_bf16(Bt[n][k], At[m][k], acc[ai][bj][m][n], 0, 0, 0); __builtin_amdgcn_s_setprio(0); } while (0)
#define PG8_WAIT_V(n) asm volatile("s_waitcnt vmcnt(" #n ")" ::: "memory")
#define PG8_WAIT_L(n) asm volatile("s_waitcnt lgkmcnt(" #n ")" ::: "memory")
#define PG8_BAR __builtin_amdgcn_s_barrier()
#define PG8_SCHED __builtin_amdgcn_sched_barrier(0)
#define PG8_APTR(u) ((const char*)g.A + (size_t)(u).pm * tstepA + (g.agt ? (size_t)((u).pn / g.agt) * (size_t)g.ags : (size_t)0))
    Unit cur, nxt; int ui = 0;
    if (!S.next(0, cur)) return;
    f32x4 acc[2][2][4][2];
#pragma unroll
    for (int a = 0; a < 2; ++a)
#pragma unroll
        for (int b = 0; b < 2; ++b)
#pragma unroll
            for (int m = 0; m < 4; ++m)
#pragma unroll
                for (int n = 0; n < 2; ++n) acc[a][b][m][n] = (f32x4){0.f, 0.f, 0.f, 0.f};
    bf16x8 At[4][2], B0[2][2], B1[2][2];
    const char* cA = PG8_APTR(cur); const char* cB = (const char*)g.Bt + (size_t)cur.pn * tstepB;
    PG8_STAGE(PG8_SB(0, 0), cB, voffB); PG8_STAGE(PG8_SB(0, 1), cB + hstepB, voffB); PG8_STAGE(PG8_SA(0, 0), cA, voffA); PG8_STAGE(PG8_SA(0, 1), cA + hstepA, voffA);
    if (wr == 1) PG8_BAR;
    PG8_WAIT_V(2); PG8_BAR;
    PG8_STAGE(PG8_SB(1, 0), cB + kstep, voffB); PG8_STAGE(PG8_SA(1, 0), cA + kstep, voffA); PG8_STAGE(PG8_SB(1, 1), cB + hstepB + kstep, voffB);
    PG8_WAIT_V(6); PG8_BAR;
    for (;;) {
        const bool has_next = S.next(ui + 1, nxt);
        const char* nA = has_next ? PG8_APTR(nxt) : cA; const char* nB = has_next ? (const char*)g.Bt + (size_t)nxt.pn * tstepB : cB;
        for (int t = 0; t < nt; t += 2) {
            const bool last = (t == nt - 2);
            const char* a1 = cA + (size_t)(t + 1) * kstep;
            const char* a2 = last ? nA : cA + (size_t)(t + 2) * kstep; const char* b2 = last ? nB : cB + (size_t)(t + 2) * kstep;
            const char* a3 = a2 + kstep; const char* b3 = b2 + kstep;
            PG8_LDB(B0, 0, 0); PG8_LDB(B1, 0, 1); PG8_SCHED; PG8_LDA(At, 0, 0); PG8_STAGE(PG8_SA(1, 1), a1 + hstepA, voffA);
            PG8_WAIT_V(8); PG8_WAIT_L(0); PG8_BAR; PG8_MMA(0, 0, At, B0); PG8_MMA(0, 1, At, B1); PG8_BAR; PG8_SCHED;
            PG8_LDA(At, 0, 1); PG8_STAGE(PG8_SB(0, 0), b2, voffB); PG8_STAGE(PG8_SB(0, 1), b2 + hstepB, voffB); PG8_STAGE(PG8_SA(0, 0), a2, voffA);
            PG8_WAIT_V(8); PG8_WAIT_L(0); PG8_BAR; PG8_MMA(1, 0, At, B0); PG8_MMA(1, 1, At, B1); PG8_BAR; PG8_SCHED;
            PG8_LDB(B0, 1, 0); PG8_LDB(B1, 1, 1); PG8_SCHED; PG8_LDA(At, 1, 0); PG8_STAGE(PG8_SA(0, 1), a2 + hstepA, voffA);
            PG8_WAIT_V(8); PG8_WAIT_L(0); PG8_BAR; PG8_MMA(0, 0, At, B0); PG8_MMA(0, 1, At, B1); PG8_BAR; PG8_SCHED;
            PG8_LDA(At, 1, 1); PG8_STAGE(PG8_SB(1, 0), b3, voffB); PG8_STAGE(PG8_SB(1, 1), b3 + hstepB, voffB); PG8_STAGE(PG8_SA(1, 0), a3, voffA);
            PG8_WAIT_V(8); PG8_WAIT_L(0); PG8_BAR; PG8_MMA(1, 0, At, B0); PG8_MMA(1, 1, At, B1); PG8_BAR; PG8_SCHED;
        }
        if (wr == 0) PG8_BAR;
        { const unsigned m_ = (unsigned)launder_i(-1); const int ln_ = (int)__builtin_amdgcn_mbcnt_hi(m_, __builtin_amdgcn_mbcnt_lo(m_, 0u));
          E(acc, cur, wr, wc, ln_ & 15, ln_ >> 4); }
        if (!has_next) break;
#pragma unroll
        for (int a = 0; a < 2; ++a)
#pragma unroll
            for (int b = 0; b < 2; ++b)
#pragma unroll
                for (int m = 0; m < 4; ++m)
#pragma unroll
                    for (int n = 0; n < 2; ++n) acc[a][b][m][n] = (f32x4){0.f, 0.f, 0.f, 0.f};
        cur = nxt; cA = nA; cB = nB; ++ui;
        if (wr == 1) PG8_BAR;
    }
    PG8_WAIT_V(0);
    PG8_BAR;
#undef PG8_SA
#undef PG8_SB
#undef PG8_STAGE
#undef PG8_LDA
#undef PG8_LDB
#undef PG8_MMA
#undef PG8_WAIT_V
#undef PG8_WAIT_L
#undef PG8_BAR
#undef PG8_SCHED
#undef PG8_APTR
}

template <bool IN16, bool OUT16>
struct EpiRes {
    static constexpr bool PERM = true;
    const void* xin; void* xout; const float* gate;
    bf16_t* xs; const float* gn; const float* scp; float* ss;
    __device__ __forceinline__ void operator()(const f32x4 (&acc)[2][2][4][2], const Unit& u, int wr, int wc, int fr, int fq) const {
        const int row0 = u.pm * BM + wr * 64 + fr, col0 = u.pn * BM + wc * 32 + 8 * fq;
        const float* gp = gate + (size_t)(u.pm >> 5) * 6144;
        f32x4 gv[2][2], gm[2][2];
#pragma unroll
        for (int bj = 0; bj < 2; ++bj)
#pragma unroll
            for (int n = 0; n < 2; ++n) { gv[bj][n] = *(const f32x4*)(gp + col0 + bj * HALF + n * 4);
                if (xs) gm[bj][n] = *(const f32x4*)(gn + col0 + bj * HALF + n * 4) * (*(const f32x4*)(scp + (size_t)(u.pm >> 5) * 6144 + col0 + bj * HALF + n * 4) + 1.0f); }
        constexpr int MB = IN16 ? 4 : 2;
#pragma unroll
        for (int aim = 0; aim < 8; aim += MB) { const int ai = aim >> 2;
            u32x4 xi[4][2]; f32x4 xf[4][2][2];
#pragma unroll
            for (int m = aim & 3; m < (aim & 3) + MB; ++m) { const size_t off = (size_t)(row0 + ai * HALF + m * 16) * DM + col0;
#pragma unroll
                for (int bj = 0; bj < 2; ++bj) {
                    if (IN16) xi[m][bj] = *(const u32x4*)((const bf16_t*)xin + off + bj * HALF);
                    else { xf[m][bj][0] = *(const f32x4*)((const float*)xin + off + bj * HALF); xf[m][bj][1] = *(const f32x4*)((const float*)xin + off + bj * HALF + 4); } } }
            asm volatile("" ::: "memory");
#pragma unroll
            for (int m = aim & 3; m < (aim & 3) + MB; ++m) { const size_t row = (size_t)(row0 + ai * HALF + m * 16), off = row * DM + col0; float sq = 0.f;
#pragma unroll
                for (int bj = 0; bj < 2; ++bj) { u32x4 o, yo; f32x4 xv[2];
                    if (IN16) { const u32x4 x4 = xi[m][bj];
                        xv[0] = (f32x4){bf2f(x4.x & 0xffff), bf2f(x4.x >> 16), bf2f(x4.y & 0xffff), bf2f(x4.y >> 16)}; xv[1] = (f32x4){bf2f(x4.z & 0xffff), bf2f(x4.z >> 16), bf2f(x4.w & 0xffff), bf2f(x4.w >> 16)}; }
                    else { xv[0] = xf[m][bj][0]; xv[1] = xf[m][bj][1]; }
#pragma unroll
                    for (int n = 0; n < 2; ++n) {
                        const f32x4 y = xv[n] + gv[bj][n] * acc[ai][bj][m][n];
                        if (OUT16) { yo[2 * n] = cvtpk(y[0], y[1]); yo[2 * n + 1] = cvtpk(y[2], y[3]); }
                        else *(f32x4*)((float*)xout + off + bj * HALF + n * 4) = y;
                        if (xs) { const f32x4 z = y * gm[bj][n]; o[2 * n] = cvtpk(z[0], z[1]); o[2 * n + 1] = cvtpk(z[2], z[3]); }
                        if (ss) sq += (y[0] * y[0] + y[1] * y[1]) + (y[2] * y[2] + y[3] * y[3]); }
                    if (OUT16) *(u32x4*)((bf16_t*)xout + off + bj * HALF) = yo;
                    if (xs) *(u32x4*)(xs + off + bj * HALF) = o; }
                if (ss) { sq += lane_get_f(sq, (fr + 16 * fq) ^ 16); sq += lane_get_f(sq, (fr + 16 * fq) ^ 32);
                    if (fq == 0) atomicAdd(ss + row, sq); } } }
    }
};
struct EpiPlain {
    static constexpr bool PERM = true;
    bf16_t* O; int ldc;
    __device__ __forceinline__ void operator()(const f32x4 (&acc)[2][2][4][2], const Unit& u, int wr, int wc, int fr, int fq) const {
        const int row0 = u.pm * BM + wr * 64 + fr, col0 = u.pn * BM + wc * 32 + 8 * fq;
#pragma unroll
        for (int ai = 0; ai < 2; ++ai)
#pragma unroll
            for (int m = 0; m < 4; ++m) { bf16_t* rowp = O + (size_t)(row0 + ai * HALF + m * 16) * ldc + col0;
#pragma unroll
                for (int bj = 0; bj < 2; ++bj) { const f32x4 v0 = acc[ai][bj][m][0], v1 = acc[ai][bj][m][1];
                    u32x4 w; w.x = cvtpk(v0[0], v0[1]); w.y = cvtpk(v0[2], v0[3]); w.z = cvtpk(v1[0], v1[1]); w.w = cvtpk(v1[2], v1[3]);
                    *(u32x4*)(rowp + bj * HALF) = w; } }
    }
};
__device__ __forceinline__ float sigm(float x) { return __builtin_amdgcn_rcpf(1.0f + __builtin_amdgcn_exp2f(-x * LOG2E)); }
struct EpiGate {
    static constexpr bool PERM = true;
    const bf16_t* Z; bf16_t* Y; const float* bias; const float* ss;
    __device__ __forceinline__ void operator()(const f32x4 (&acc)[2][2][4][2], const Unit& u, int wr, int wc, int fr, int fq) const {
        const int cp = u.pn / 3, kk = u.pn - 3 * cp, cin = wc * 32 + 8 * fq;
        const int row0 = u.pm * BM + wr * 64 + fr;
        int zcol[2], ycol[2];
#pragma unroll
        for (int bj = 0; bj < 2; ++bj) { const int br = kk == 2 ? 2 : bj, blk = kk == 2 ? 2 * cp + bj : 2 * cp + kk; ycol[bj] = blk * 128 + cin; zcol[bj] = br * 1024 + ycol[bj]; }
        f32x4 bv[2][2];
#pragma unroll
        for (int bj = 0; bj < 2; ++bj)
#pragma unroll
            for (int n = 0; n < 2; ++n) bv[bj][n] = *(const f32x4*)(bias + (size_t)(u.pm >> 5) * NCB1 + u.pn * BM + bj * HALF + cin + 4 * n) * (-LOG2E);
#pragma unroll
        for (int ai = 0; ai < 2; ++ai) {
            float ssr[4]; u32x4 zz[4][2], yy[4][2];
#pragma unroll
            for (int m = 0; m < 4; ++m) { const size_t row = (size_t)(row0 + ai * HALF + m * 16);
                ssr[m] = ss[row];
#pragma unroll
                for (int bj = 0; bj < 2; ++bj) { zz[m][bj] = *(const u32x4*)(Z + row * 3072 + zcol[bj]); if (kk == 2) yy[m][bj] = *(const u32x4*)(Y + row * DM + ycol[bj]); } }
            asm volatile("" ::: "memory");
#pragma unroll
            for (int m = 0; m < 4; ++m) { const size_t row = (size_t)(row0 + ai * HALF + m * 16);
                const float rs = __builtin_amdgcn_rsqf(ssr[m] * (1.0f / DM) + RMS_EPS) * (-LOG2E);
                float t[2][8];
#pragma unroll
                for (int bj = 0; bj < 2; ++bj) { const f32x4 v0 = acc[ai][bj][m][0] * rs + bv[bj][0], v1 = acc[ai][bj][m][1] * rs + bv[bj][1];
                    const u32x4 z = zz[m][bj];
#define SG_(x) __builtin_amdgcn_rcpf(1.0f + __builtin_amdgcn_exp2f(x))
                    t[bj][0] = SG_(v0[0]) * bf2f(z.x & 0xffff); t[bj][1] = SG_(v0[1]) * bf2f(z.x >> 16); t[bj][2] = SG_(v0[2]) * bf2f(z.y & 0xffff); t[bj][3] = SG_(v0[3]) * bf2f(z.y >> 16);
                    t[bj][4] = SG_(v1[0]) * bf2f(z.z & 0xffff); t[bj][5] = SG_(v1[1]) * bf2f(z.z >> 16); t[bj][6] = SG_(v1[2]) * bf2f(z.w & 0xffff); t[bj][7] = SG_(v1[3]) * bf2f(z.w >> 16);
#undef SG_
                }
                if (kk == 2) {
#pragma unroll
                    for (int bj = 0; bj < 2; ++bj) { const u32x4 y = yy[m][bj];
                        t[bj][0] += bf2f(y.x & 0xffff); t[bj][1] += bf2f(y.x >> 16); t[bj][2] += bf2f(y.y & 0xffff); t[bj][3] += bf2f(y.y >> 16);
                        t[bj][4] += bf2f(y.z & 0xffff); t[bj][5] += bf2f(y.z >> 16); t[bj][6] += bf2f(y.w & 0xffff); t[bj][7] += bf2f(y.w >> 16);
                        u32x4 w; w.x = cvtpk(t[bj][0], t[bj][1]); w.y = cvtpk(t[bj][2], t[bj][3]); w.z = cvtpk(t[bj][4], t[bj][5]); w.w = cvtpk(t[bj][6], t[bj][7]);
                        *(u32x4*)(Y + row * DM + ycol[bj]) = w; }
                } else {
                    u32x4 w; w.x = cvtpk(t[0][0] + t[1][0], t[0][1] + t[1][1]); w.y = cvtpk(t[0][2] + t[1][2], t[0][3] + t[1][3]);
                    w.z = cvtpk(t[0][4] + t[1][4], t[0][5] + t[1][5]); w.w = cvtpk(t[0][6] + t[1][6], t[0][7] + t[1][7]);
                    *(u32x4*)(Y + row * DM + ycol[0]) = w; } } }
    }
};
struct EpiSwiGLU {
    static constexpr bool PERM = true;
    bf16_t* O; const float* bias; const float* ss;
    __device__ __forceinline__ void operator()(const f32x4 (&acc)[2][2][4][2], const Unit& u, int wr, int wc, int fr, int fq) const {
        const int row0 = u.pm * BM + wr * 64 + fr, col0 = u.pn * HALF + wc * 32 + 8 * fq;
        const float* bp = bias + (size_t)(u.pm >> 5) * NCB2 + u.pn * BM + wc * 32 + 8 * fq;
        const f32x4 bg0 = *(const f32x4*)bp, bg1 = *(const f32x4*)(bp + 4), bu0 = *(const f32x4*)(bp + HALF), bu1 = *(const f32x4*)(bp + HALF + 4);
        float ssr[2][4];
#pragma unroll
        for (int ai = 0; ai < 2; ++ai)
#pragma unroll
            for (int m = 0; m < 4; ++m) ssr[ai][m] = ss[row0 + ai * HALF + m * 16];
        asm volatile("" ::: "memory");
#pragma unroll
        for (int ai = 0; ai < 2; ++ai)
#pragma unroll
            for (int m = 0; m < 4; ++m) { const size_t row = (size_t)(row0 + ai * HALF + m * 16); bf16_t* rowp = O + row * FFH + col0;
                const float rs = __builtin_amdgcn_rsqf(ssr[ai][m] * (1.0f / DM) + RMS_EPS);
                const f32x4 g0 = acc[ai][0][m][0] * rs + bg0, g1 = acc[ai][0][m][1] * rs + bg1, u0 = acc[ai][1][m][0] * rs + bu0, u1 = acc[ai][1][m][1] * rs + bu1;
                u32x4 w; w.x = cvtpk(g0[0] * sigm(g0[0]) * u0[0], g0[1] * sigm(g0[1]) * u0[1]); w.y = cvtpk(g0[2] * sigm(g0[2]) * u0[2], g0[3] * sigm(g0[3]) * u0[3]);
                w.z = cvtpk(g1[0] * sigm(g1[0]) * u1[0], g1[1] * sigm(g1[1]) * u1[1]); w.w = cvtpk(g1[2] * sigm(g1[2]) * u1[2], g1[3] * sigm(g1[3]) * u1[3]);
                *(u32x4*)rowp = w; }
    }
};
struct EpiProj {
    static constexpr bool PERM = true;
    unsigned char* ws; const float* bias_; const float* ss;
    __device__ __forceinline__ void operator()(const f32x4 (&acc)[2][2][4][2], const Unit& u, int wr, int wc, int fr, int fq) const {
        const int row0 = u.pm * BM + wr * 64 + fr; const float* bias = bias_ + (size_t)(u.pm >> 5) * NCB1;
        float rsv[2][4];
#pragma unroll
        for (int ai = 0; ai < 2; ++ai)
#pragma unroll
            for (int m = 0; m < 4; ++m) rsv[ai][m] = __builtin_amdgcn_rsqf(ss[row0 + ai * HALF + m * 16] * (1.0f / DM) + RMS_EPS);
        const float* COS = (const float*)(ws + WS_COS); const float* SIN = (const float*)(ws + WS_SIN);
#pragma unroll
        for (int bj = 0; bj < 2; ++bj) {
            const int g = u.pn * 8 + bj * 4 + wc;
            if (g >= 115) continue;
            size_t dofs; int ld, col; bool rope = false; float sc = 1.0f;
            if (g < 12)       { dofs = P_QA; ld = 384; col = g * 32; rope = !(g & 1); sc = QSCALE; }
            else if (g < 24)  { dofs = P_KA; ld = 384; col = (g - 12) * 32; rope = !(g & 1); }
            else if (g < 36)  { dofs = P_VA; ld = 384; col = (g - 24) * 32; }
            else if (g < 52)  { dofs = P_QI; ld = 512; col = (g - 36) * 32; rope = !(g & 1); }
            else if (g < 54)  { dofs = P_KI; ld = 64; col = (g - 52) * 32; rope = (g == 52); }
            else if (g == 54) { dofs = 0; ld = 0; col = 0; }
            else if (g < 65)  { dofs = P_QB; ld = 320; col = (g - 55) * 32; sc = QSCALE; }
            else if (g < 75)  { dofs = P_KB; ld = 320; col = (g - 65) * 32; }
            else if (g < 85)  { dofs = P_VB; ld = 320; col = (g - 75) * 32; }
            else if (g < 95)  { dofs = P_QC; ld = 320; col = (g - 85) * 32; sc = QSCALE; }
            else if (g < 105) { dofs = P_KC; ld = 320; col = (g - 95) * 32; }
            else              { dofs = P_VC; ld = 320; col = (g - 105) * 32; }
            const f32x4 bv0 = *(const f32x4*)(bias + g * 32 + 8 * fq), bv1 = *(const f32x4*)(bias + g * 32 + 8 * fq + 4);
            if (g == 54) {
                float* WI = (float*)(ws + WS_WI); float* FC = (float*)(ws + WS_FC);
#pragma unroll
                for (int ai = 0; ai < 2; ++ai)
#pragma unroll
                    for (int m = 0; m < 4; ++m) { const size_t row = (size_t)(row0 + ai * HALF + m * 16);
                        const f32x4 v0 = acc[ai][bj][m][0] * rsv[ai][m] + bv0, v1 = acc[ai][bj][m][1] * rsv[ai][m] + bv1;
                        if (fq == 0) { *(f32x4*)(WI + row * 8) = v0 * WI_SCALE; *(f32x4*)(WI + row * 8 + 4) = v1 * WI_SCALE; }
                        else if (fq == 1) { float o[8];
#pragma unroll
                            for (int j = 0; j < 8; ++j) { const float x = j < 4 ? v0[j & 3] : v1[j & 3];
                                o[j] = fminf(x, 0.f) - 0.6931471805599453f * __builtin_amdgcn_logf(1.0f + __builtin_amdgcn_exp2f(-fabsf(x) * LOG2E)); }
                            *(f32x4*)(FC + row * 8) = (f32x4){o[0], o[1], o[2], o[3]}; *(f32x4*)(FC + row * 8 + 4) = (f32x4){o[4], o[5], o[6], o[7]}; } }
                continue;
            }
            bf16_t* dst = (bf16_t*)(ws + dofs);
            f32x4 csn = {}, snn = {};
            if (rope && fq < 2) { csn = *(const f32x4*)(COS + (size_t)row0 * 8 + 4 * fq); snn = *(const f32x4*)(SIN + (size_t)row0 * 8 + 4 * fq); }
#pragma unroll
            for (int ai = 0; ai < 2; ++ai)
#pragma unroll
                for (int m = 0; m < 4; ++m) { const size_t row = (size_t)(row0 + ai * HALF + m * 16);
                    f32x4 v0 = acc[ai][bj][m][0] * rsv[ai][m] + bv0, v1 = acc[ai][bj][m][1] * rsv[ai][m] + bv1;
                    const f32x4 cs = csn, sn = snn;
                    if (rope && fq < 2 && (ai * 4 + m) < 7) { const size_t rown = (size_t)(row0 + ((ai * 4 + m + 1) >> 2) * HALF + ((ai * 4 + m + 1) & 3) * 16);
                        csn = *(const f32x4*)(COS + rown * 8 + 4 * fq); snn = *(const f32x4*)(SIN + rown * 8 + 4 * fq); }
                    if (rope && fq < 2) {
                        f32x4 o0, o1;
                        o0[0] = v0[0] * cs[0] - v0[1] * sn[0]; o0[1] = v0[1] * cs[0] + v0[0] * sn[0];
                        o0[2] = v0[2] * cs[1] - v0[3] * sn[1]; o0[3] = v0[3] * cs[1] + v0[2] * sn[1];
                        o1[0] = v1[0] * cs[2] - v1[1] * sn[2]; o1[1] = v1[1] * cs[2] + v1[0] * sn[2];
                        o1[2] = v1[2] * cs[3] - v1[3] * sn[3]; o1[3] = v1[3] * cs[3] + v1[2] * sn[3];
                        v0 = o0; v1 = o1; }
                    v0 = v0 * sc; v1 = v1 * sc;
                    u32x4 w; w.x = cvtpk(v0[0], v0[1]); w.y = cvtpk(v0[2], v0[3]); w.z = cvtpk(v1[0], v1[1]); w.w = cvtpk(v1[2], v1[3]);
                    *(u32x4*)(dst + row * ld + col + 8 * fq) = w; }
        }
    }
};
}

__host__ __device__ __forceinline__ int map_p1(int n) {
    const int g = n >> 5, p = n & 31;
    const int pr = p < 16 ? ((p >> 1) + 8 * (p & 1)) : p;
    if (g < 12) return SRC_QA + g * 32 + ((g & 1) ? p : pr);
    if (g < 24) return SRC_KA + (g - 12) * 32 + ((g & 1) ? p : pr);
    if (g < 36) return SRC_VA + (g - 24) * 32 + p;
    if (g < 52) return SRC_QI + (g - 36) * 32 + ((g & 1) ? p : pr);
    if (g < 54) return SRC_KI + (g - 52) * 32 + ((g == 52) ? pr : p);
    if (g == 54) return p < 8 ? SRC_WI + p : (p < 13 ? SRC_F + (p - 8) : -1);
    if (g < 85) return SRC_B + (g - 55) * 32 + p;
    if (g < 115) return SRC_C + (g - 85) * 32 + p;
    return -1;
}
__host__ __device__ __forceinline__ int map_gate(int n) { const int t = n >> 8, w = n & 255, bj = w >> 7, cw = w & 127, cp = t / 3, kk = t % 3;
    const int br = kk == 2 ? 2 : bj, blk = kk == 2 ? 2 * cp + bj : 2 * cp + kk; return br * 1024 + blk * 128 + cw; }
__host__ __device__ __forceinline__ int map_f1(int r) { const int t = r >> 8, w = r & 255; return w < 128 ? 128 * t + w : FFH + 128 * t + (w - 128); }

struct Args { const void* in[15]; float* out; unsigned char* ws; int ph_lo, ph_hi; };
struct Frame {
    LAS unsigned char* lds; unsigned* ctl; unsigned char* ws;
    int tid, lane, wave, G, bid;
};

template <class CM>
__device__ __forceinline__ void transpose_item(const float* src, int ldsrc, int kvalid, bf16_t* dst, int lddst, int n0, int k0, LAS float* scr, int lane, CM cm) {
    const int sc = cm(n0 + (lane & 31));
#pragma unroll 8
    for (int i = 0; i < 32; ++i) { const int kk = 2 * i + (lane >> 5); const int k = k0 + kk;
        scr[kk * 33 + (lane & 31)] = (sc >= 0 && k < kvalid) ? src[(size_t)k * ldsrc + sc] : 0.f; }
    LDS_WAIT(); asm volatile("" ::: "memory");
    const int c = lane & 7;
#pragma unroll
    for (int j = 0; j < 4; ++j) { const int n = (lane >> 3) + 8 * j; const LAS float* s = scr + (8 * c) * 33 + n;
        u32x4 o; o.x = pk2(s[0 * 33], s[1 * 33]); o.y = pk2(s[2 * 33], s[3 * 33]); o.z = pk2(s[4 * 33], s[5 * 33]); o.w = pk2(s[6 * 33], s[7 * 33]);
        *(u32x4*)(dst + (size_t)(n0 + n) * lddst + k0 + 8 * c) = o; }
    LDS_WAIT(); asm volatile("" ::: "memory");
}
typedef float f32x4_u __attribute__((ext_vector_type(4), aligned(4)));
template <class CM>
__device__ __forceinline__ void transpose_item_vec(const float* src, int ldsrc, int kvalid, bf16_t* dst, int lddst, int n0, int k0, int lane, CM cm) {
    const int ln = lane & 7, lk = lane >> 3, sc = cm(n0 + 4 * ln), kb = k0 + 8 * lk;
    f32x4 v[8];
#pragma unroll
    for (int j = 0; j < 8; ++j) v[j] = (kb + j < kvalid) ? (f32x4)(*(const f32x4_u*)(src + (size_t)(kb + j) * ldsrc + sc)) : (f32x4){0.f, 0.f, 0.f, 0.f};
#pragma unroll
    for (int i = 0; i < 4; ++i) { u32x4 o; o.x = pk2(v[0][i], v[1][i]); o.y = pk2(v[2][i], v[3][i]); o.z = pk2(v[4][i], v[5][i]); o.w = pk2(v[6][i], v[7][i]);
        *(u32x4*)(dst + (size_t)(n0 + 4 * ln + i) * lddst + kb) = o; }
}
struct CmP1 { __device__ int operator()(int n) const { return map_p1(n); } };
struct CmOff { int off; __device__ int operator()(int n) const { return off + n; } };
struct CmF1 { __device__ int operator()(int n) const { return map_f1(n); } };

__device__ __forceinline__ void phase_prologue(Frame& F, const void* const (&ain)[15]) {
    const float* c_in = (const float*)ain[1]; const int* pos = (const int*)ain[2];
    const float* ada_w = (const float*)ain[3]; const float* ada_b = (const float*)ain[4];
    const float* w_in = (const float*)ain[6]; const float* b_in = (const float*)ain[7];
    const float* w_branch = (const float*)ain[9]; const float* w_out = (const float*)ain[10];
    const float* w_f1 = (const float*)ain[12]; const float* w_f2 = (const float*)ain[13];
    LAS float* scr = (LAS float*)(F.lds + F.wave * 16384);
    const int gw = F.bid * 8 + F.wave, NGW = F.G * 8;
    constexpr int I_P1 = 16 * (NP1 / 32), I_P2 = 16 * (NP2 / 32), I_BR = 3 * 6 * 32, I_OUT = 16 * 32, I_F1 = 16 * (2 * FFH / 32), I_F2 = (FFH / 64) * 32;
    constexpr int I_LAYER = I_P1 + I_P2 + I_BR + I_OUT + I_F1 + I_F2;
    for (int it = gw; it < DEPTH * I_LAYER; it += NGW) {
        const int l = it / I_LAYER; int r = it % I_LAYER;
        unsigned char* wl = F.ws + WS_W + (size_t)l * W_LAYER;
        if (r < I_P1) { const int nb = r % (NP1 / 32), kb = r / (NP1 / 32);
            const bool plain = (nb >= 24 && nb < 36) || (nb >= 55 && nb < 115) || ((nb & 1) && nb < 54);
            if (plain) transpose_item_vec(w_in + (size_t)l * DM * IN_W, IN_W, DM, (bf16_t*)(wl + W_P1), DM, nb * 32, kb * 64, F.lane, CmP1{});
            else transpose_item(w_in + (size_t)l * DM * IN_W, IN_W, DM, (bf16_t*)(wl + W_P1), DM, nb * 32, kb * 64, scr, F.lane, CmP1{});
            continue; } r -= I_P1;
        if (r < I_P2) { const int nb = r % (NP2 / 32), kb = r / (NP2 / 32); transpose_item_vec(w_in + (size_t)l * DM * IN_W, IN_W, DM, (bf16_t*)(wl + W_P2), DM, nb * 32, kb * 64, F.lane, CmOff{SRC_G + map_gate(nb * 32) - nb * 32}); continue; } r -= I_P2;
        if (r < I_BR) { const int br = r / 192, rr = r % 192, nb = rr % 32, kb = rr / 32; const int kofs = br == 0 ? 0 : (br == 1 ? 384 : 704), kv = br == 0 ? 384 : 320;
            transpose_item_vec(w_branch + (size_t)l * DM * DM + (size_t)kofs * DM, DM, kv, (bf16_t*)(wl + W_BR) + (size_t)br * 1024 * KBR, KBR, nb * 32, kb * 64, F.lane, CmOff{0}); continue; } r -= I_BR;
        if (r < I_OUT) { const int nb = r % 32, kb = r / 32;
            transpose_item_vec(w_out + (size_t)l * DM * DM, DM, DM, (bf16_t*)(wl + W_OUT), DM, nb * 32, kb * 64, F.lane, CmOff{0}); continue; } r -= I_OUT;
        if (r < I_F1) { const int nb = r % (2 * FFH / 32), kb = r / (2 * FFH / 32); transpose_item_vec(w_f1 + (size_t)l * DM * 2 * FFH, 2 * FFH, DM, (bf16_t*)(wl + W_F1), DM, nb * 32, kb * 64, F.lane, CmF1{}); continue; } r -= I_F1;
        { const int nb = r % 32, kb = r / 32; transpose_item_vec(w_f2 + (size_t)l * FFH * DM, DM, FFH, (bf16_t*)(wl + W_F2), FFH, nb * 32, kb * 64, F.lane, CmOff{0}); }
    }
    __syncthreads();
    {
        LAS float* red = (LAS float*)F.lds;
        LAS float* cs = (LAS float*)(F.lds + 8192);
        for (int i = F.tid; i < 4096; i += 512) { const float x = c_in[i]; cs[i] = x / (1.0f + expf(-x)); }
        __syncthreads();
        float* mod = (float*)(F.ws + WS_MOD);
        for (int it = F.bid; it < DEPTH * 96; it += F.G) {
            const int l = it / 96, j = (it % 96) * 64 + (F.tid & 63), ks = F.tid >> 6;
            const float* wp = ada_w + (size_t)l * DM * 6144 + (size_t)(ks * 128) * 6144 + j;
            float s0 = 0.f, s1 = 0.f, s2 = 0.f, s3 = 0.f;
#pragma unroll 8
            for (int k = 0; k < 128; ++k) { const float w = wp[(size_t)k * 6144]; const int kk = ks * 128 + k;
                s0 += w * cs[kk]; s1 += w * cs[1024 + kk]; s2 += w * cs[2048 + kk]; s3 += w * cs[3072 + kk]; }
            red[(ks * 64 + (F.tid & 63)) * 4 + 0] = s0; red[(ks * 64 + (F.tid & 63)) * 4 + 1] = s1; red[(ks * 64 + (F.tid & 63)) * 4 + 2] = s2; red[(ks * 64 + (F.tid & 63)) * 4 + 3] = s3;
            __syncthreads();
            if (F.tid < 256) { const int jj = F.tid & 63, bb = F.tid >> 6; float s = ada_b[l * 6144 + (it % 96) * 64 + jj];
#pragma unroll
                for (int q = 0; q < 8; ++q) s += red[(q * 64 + jj) * 4 + bb];
                mod[((size_t)l * 4 + bb) * 6144 + (it % 96) * 64 + jj] = s; }
            __syncthreads();
        }
    }
    {
        float* COS = (float*)(F.ws + WS_COS); float* SIN = (float*)(F.ws + WS_SIN);
        for (int i = F.bid * 512 + F.tid; i < MTOK * 8; i += F.G * 512) { const int row = i >> 3, d = i & 7;
            const float inv = (float)pow(500000.0, -(double)d / 8.0);
            const float ang = (float)pos[row] * inv;
            COS[i] = (float)cos((double)ang); SIN[i] = (float)sin((double)ang); }
        float* bp1 = (float*)(F.ws + WS_BP1); float* bp2 = (float*)(F.ws + WS_BP2);
        for (int i = F.bid * 512 + F.tid; i < DEPTH * NP1; i += F.G * 512) { const int l = i / NP1, n = i % NP1, s = map_p1(n); bp1[i] = s >= 0 ? b_in[l * IN_W + s] : 0.f; }
        for (int i = F.bid * 512 + F.tid; i < DEPTH * NP2; i += F.G * 512) { const int l = i / NP2, n = i % NP2; bp2[i] = b_in[l * IN_W + SRC_G + map_gate(n)]; }
    }
}

__device__ __forceinline__ void phase_norm(Frame& F, const float* x, const float* g, const float* modb  , int sh_off, int sc_off, bf16_t* h) {
    const int gw = F.bid * 8 + F.wave, NGW = F.G * 8;
    for (int m = gw; m < MTOK; m += NGW) {
        const float* mb = modb + (size_t)(m >> 13) * 6144;
        const f32x4* xr = (const f32x4*)(x + (size_t)m * DM) + F.lane;
        f32x4 v[4]; float s = 0.f;
#pragma unroll
        for (int j = 0; j < 4; ++j) { v[j] = xr[64 * j]; s += (v[j].x * v[j].x + v[j].y * v[j].y) + (v[j].z * v[j].z + v[j].w * v[j].w); }
        const float rstd = 1.0f / sqrtf(wave_sum(s, F.lane) * (1.0f / DM) + RMS_EPS);
        u32x2* o8 = (u32x2*)(h + (size_t)m * DM) + F.lane;
#pragma unroll
        for (int j = 0; j < 4; ++j) { const int c = 4 * F.lane + 256 * j;
            const f32x4 gg = *(const f32x4*)(g + c), sc = *(const f32x4*)(mb + sc_off + c), sh = *(const f32x4*)(mb + sh_off + c);
            const f32x4 y = (v[j] * rstd * gg) * (sc + 1.0f) + sh;
            u32x2 o; o.x = pk2(y.x, y.y); o.y = pk2(y.z, y.w); o8[64 * j] = o; }
    }
}
__device__ __forceinline__ void phase_first(Frame& F, const float* x, const float* g1, const float* mod  , const float* n2g_unused) {
    const int gw = F.bid * 8 + F.wave, NGW = F.G * 8; (void)n2g_unused;
    bf16_t* XS = (bf16_t*)(F.ws + WS_H); float* SS = (float*)(F.ws + WS_SS);
    for (int m0 = gw; m0 < MTOK; m0 += 2 * NGW) {
        const int m1 = m0 + NGW < MTOK ? m0 + NGW : m0;
        f32x4 v[2][4]; float s[2] = {0.f, 0.f};
#pragma unroll
        for (int q = 0; q < 2; ++q) { const f32x4* xr = (const f32x4*)(x + (size_t)(q ? m1 : m0) * DM) + F.lane;
#pragma unroll
            for (int j = 0; j < 4; ++j) v[q][j] = xr[64 * j]; }
#pragma unroll
        for (int q = 0; q < 2; ++q) {
#pragma unroll
            for (int j = 0; j < 4; ++j) s[q] += (v[q][j].x * v[q][j].x + v[q][j].y * v[q][j].y) + (v[q][j].z * v[q][j].z + v[q][j].w * v[q][j].w);
            s[q] = wave_sum(s[q], F.lane); }
#pragma unroll
        for (int q = 0; q < 2; ++q) { const int m = q ? m1 : m0; if (q && m1 == m0) break;
            const float* mb = mod + (size_t)(m >> 13) * 6144;
            if (F.lane < 4) SS[(size_t)F.lane * MTOK + m] = F.lane == 0 ? s[q] : 0.f;
            if (F.lane == 4) ((float*)(F.ws + WS_SSF))[m] = 0.f;
            u32x2* o8 = (u32x2*)(XS + (size_t)m * DM) + F.lane;
#pragma unroll
            for (int j = 0; j < 4; ++j) { const int c = 4 * F.lane + 256 * j;
                const f32x4 gg = *(const f32x4*)(g1 + c), sc = *(const f32x4*)(mb + 1024 + c);
                const f32x4 y = v[q][j] * gg * (sc + 1.0f);
                u32x2 o; o.x = pk2(y.x, y.y); o.y = pk2(y.z, y.w); o8[64 * j] = o; } }
    }
    float* CB = (float*)(F.ws + WS_CB);
    const float* bp1 = (const float*)(F.ws + WS_BP1); const float* bp2 = (const float*)(F.ws + WS_BP2);
    constexpr int NIT = DEPTH * (NCB1 + NCB2);
    for (int it = gw; it < NIT; it += NGW) {
        const int l = it / (NCB1 + NCB2), r = it % (NCB1 + NCB2);
        const unsigned char* wl = F.ws + WS_W + (size_t)l * W_LAYER;
        const bf16_t* wrow; float bias; int shoff; float* dst; int dstride;
        if (r < NP1) { wrow = (const bf16_t*)(wl + W_P1) + (size_t)r * DM; bias = bp1[l * NP1 + r]; shoff = 0; dst = CB + (size_t)l * 4 * NCB1 + r; dstride = NCB1; }
        else if (r < NCB1) { wrow = (const bf16_t*)(wl + W_P2) + (size_t)(r - NP1) * DM; bias = bp2[l * NP2 + (r - NP1)]; shoff = 0; dst = CB + (size_t)l * 4 * NCB1 + r; dstride = NCB1; }
        else { wrow = (const bf16_t*)(wl + W_F1) + (size_t)(r - NCB1) * DM; bias = 0.f; shoff = 3072; dst = CB + CB2_OFF + (size_t)l * 4 * NCB2 + (r - NCB1); dstride = NCB2; }
        const u32x4 w0 = *(const u32x4*)(wrow + F.lane * 8), w1 = *(const u32x4*)(wrow + 512 + F.lane * 8);
        float wv[16];
#pragma unroll
        for (int e = 0; e < 4; ++e) { wv[2 * e] = bf2f(w0[e] & 0xffff); wv[2 * e + 1] = bf2f(w0[e] >> 16); wv[8 + 2 * e] = bf2f(w1[e] & 0xffff); wv[9 + 2 * e] = bf2f(w1[e] >> 16); }
        float dd[4];
#pragma unroll
        for (int bb = 0; bb < 4; ++bb) { const float* sh = mod + ((size_t)l * 4 + bb) * 6144 + shoff;
            const f32x4 a0 = *(const f32x4*)(sh + F.lane * 8), a1 = *(const f32x4*)(sh + F.lane * 8 + 4), c0 = *(const f32x4*)(sh + 512 + F.lane * 8), c1 = *(const f32x4*)(sh + 512 + F.lane * 8 + 4);
            dd[bb] = a0[0] * wv[0] + a0[1] * wv[1] + a0[2] * wv[2] + a0[3] * wv[3] + a1[0] * wv[4] + a1[1] * wv[5] + a1[2] * wv[6] + a1[3] * wv[7]
                    + c0[0] * wv[8] + c0[1] * wv[9] + c0[2] * wv[10] + c0[3] * wv[11] + c1[0] * wv[12] + c1[1] * wv[13] + c1[2] * wv[14] + c1[3] * wv[15]; }
#pragma unroll
        for (int bb = 0; bb < 4; ++bb) dd[bb] = wave_sum(dd[bb], F.lane);
        if (F.lane < 4) dst[(size_t)F.lane * dstride] = (F.lane == 0 ? dd[0] : F.lane == 1 ? dd[1] : F.lane == 2 ? dd[2] : dd[3]) + bias;
    }
}
__device__ __forceinline__ void phase_final_norm(Frame& F, float* out, const float* g) {
    const int gw = F.bid * 8 + F.wave, NGW = F.G * 8;
    const bf16_t* Y = (const bf16_t*)(F.ws + WS_Y); const float* SSF = (const float*)(F.ws + WS_SSF);
    f32x4 gg[4];
#pragma unroll
    for (int j = 0; j < 4; ++j) gg[j] = *(const f32x4*)(g + 16 * F.lane + 4 * j);
    for (int m = gw; m < MTOK; m += 2 * NGW) {
        const int m1 = m + NGW < MTOK ? m + NGW : m;
        const u32x4 a0 = *((const u32x4*)(Y + (size_t)m * DM) + 2 * F.lane), a1 = *((const u32x4*)(Y + (size_t)m * DM) + 2 * F.lane + 1);
        const u32x4 c0 = *((const u32x4*)(Y + (size_t)m1 * DM) + 2 * F.lane), c1 = *((const u32x4*)(Y + (size_t)m1 * DM) + 2 * F.lane + 1);
        const float r0 = __builtin_amdgcn_rsqf(SSF[m] * (1.0f / DM) + RMS_EPS), r1 = __builtin_amdgcn_rsqf(SSF[m1] * (1.0f / DM) + RMS_EPS);
#define FN_ROW(mm, p0, p1, rr) do { f32x4* orow = (f32x4*)(out + (size_t)(mm) * DM + 16 * F.lane); \
            orow[0] = (f32x4){bf2f(p0.x & 0xffff), bf2f(p0.x >> 16), bf2f(p0.y & 0xffff), bf2f(p0.y >> 16)} * (rr) * gg[0]; orow[1] = (f32x4){bf2f(p0.z & 0xffff), bf2f(p0.z >> 16), bf2f(p0.w & 0xffff), bf2f(p0.w >> 16)} * (rr) * gg[1]; \
            orow[2] = (f32x4){bf2f(p1.x & 0xffff), bf2f(p1.x >> 16), bf2f(p1.y & 0xffff), bf2f(p1.y >> 16)} * (rr) * gg[2]; orow[3] = (f32x4){bf2f(p1.z & 0xffff), bf2f(p1.z >> 16), bf2f(p1.w & 0xffff), bf2f(p1.w >> 16)} * (rr) * gg[3]; } while (0)
        FN_ROW(m, a0, a1, r0);
        if (m1 != m) FN_ROW(m1, c0, c1, r1);
#undef FN_ROW
    }
}

namespace att {
constexpr int NSLOT = 4, L_K = 0, L_V = 32768, L_AUX = 65536, L_TAB = 73728, L_WS = 74816, L_OST = 76864, L_END = 109632;
static_assert(L_END <= RING_BYTES, "attention LDS");
enum { ATT_A = 0, ATT_B = 1, ATT_C = 2 };
constexpr float NEG = -1.0e30f;
__device__ __forceinline__ s16x4 vtr(const LAS unsigned char* p) { typedef short v4i16_t __attribute__((ext_vector_type(4)));
    return __builtin_bit_cast(s16x4, __builtin_amdgcn_ds_read_tr16_b64_v4i16((LAS v4i16_t*)p)); }
__device__ __forceinline__ float max3f(float a, float b, float c) { float r; asm("v_max3_f32 %0, %1, %2, %3" : "=v"(r) : "v"(a), "v"(b), "v"(c)); return r; }
template <int POS> __device__ __forceinline__ float bitsel(unsigned w, float a, float b) { int m; float o;
    asm("v_bfe_i32 %0, %1, %2, 1" : "=v"(m) : "v"(w), "n"(POS)); asm("v_bfi_b32 %0, %1, %2, %3" : "=v"(o) : "v"(m), "v"(a), "v"(b)); return o; }
#define ATT_WAITBAR(n) asm volatile("s_waitcnt vmcnt(" #n ") lgkmcnt(0)\n\ts_barrier" ::: "memory")

template <int TYPE, int DUMMY = 0>
__device__ __forceinline__ void attn_unit(LAS unsigned char* lds, const bf16_t* __restrict__ Qp, const bf16_t* __restrict__ Kp, const bf16_t* __restrict__ Vp, int ld,
                                          bf16_t* Op, int b, int h, int qb, const unsigned* aux, const float* relb, int tid_) {
    const int tid = launder_v(tid_), lane = tid & 63, r32 = lane & 31, hi = lane >> 5;
    const int wid = __builtin_amdgcn_readfirstlane(tid >> 6);
    const size_t rowbase = (size_t)b * SEQ;
    const int q0 = qb * 256, qw0 = q0 + wid * 32, cq = qw0 >> 6;
    int t_lo = 0; const int t_hi = 4 * (qb + 1);
    if (TYPE == ATT_B) { t_lo = 4 * qb - 8; if (t_lo < 0) t_lo = 0; }
    int a_lo = t_lo, a_hi = cq;
    if (TYPE == ATT_B) { a_lo = cq - 8 > t_lo ? cq - 8 : t_lo; }
    if (TYPE == ATT_C) {
        const float* fn = (const float*)aux + (size_t)(b * 5 + h) * SEQ; const float lim = fn[q0] - 2.0f * relb[0] - 43.0f;
        const bool c0 = (lane < t_hi) && (fn[64 * lane + 63] < lim), c1 = (lane + 64 < t_hi) && (fn[64 * (lane + 64) + 63] < lim);
        t_lo = ((int)__builtin_popcountll(__ballot(c0)) + (int)__builtin_popcountll(__ballot(c1))) & ~1;
        if (t_lo > t_hi - 4) t_lo = t_hi - 4;
        a_lo = t_lo; a_hi = (qw0 + 31) >> 6; }
    bf16x8 qf[4];
    { const bf16_t* Qw = Qp + (rowbase + qw0 + r32) * ld + h * 64 + hi * 8;
#pragma unroll
      for (int d0 = 0; d0 < 4; ++d0) qf[d0] = *(const bf16x8*)(Qw + d0 * 16); }
    const bf16_t* ksrc = Kp + (rowbase + lane) * ld + h * 64 + wid * 8;
    const bf16_t* vsrc = Vp + (rowbase + 16 * (wid & 3) + (lane >> 2)) * ld + h * 64 + (wid >> 2) * 32 + (lane & 3) * 8;
    const unsigned* asrc = aux;
    if (TYPE == ATT_A) asrc = aux + ((size_t)(b * 256 + qb * 8 + wid) * 128) * 64 + lane;
    if (TYPE == ATT_C) asrc = aux + (size_t)(b * 5 + h) * SEQ + lane;
    LAS unsigned char* auxl = lds + L_AUX + wid * 1024;
#define ATT_DMA(t) do { const int sl_ = (t) & (NSLOT - 1); \
        __builtin_amdgcn_global_load_lds((const unsigned*)(ksrc + (size_t)(t) * 64 * ld), (LAS unsigned*)(lds + L_K + sl_ * 8192 + wid * 1024), 16, 0, 0); \
        __builtin_amdgcn_global_load_lds((const unsigned*)(vsrc + (size_t)(t) * 64 * ld), (LAS unsigned*)(lds + L_V + sl_ * 8192 + wid * 1024), 16, 0, 0); \
        if (TYPE != ATT_B) __builtin_amdgcn_global_load_lds(asrc + (size_t)(t) * 64, (LAS unsigned*)(auxl + sl_ * 256), 4, 0, 0); } while (0)
#define ATT_SYNC(younger) do { if (TYPE == ATT_B) { if ((younger) >= 2) ATT_WAITBAR(4); else if ((younger) == 1) ATT_WAITBAR(2); else ATT_WAITBAR(0); } \
        else { if ((younger) >= 2) ATT_WAITBAR(6); else if ((younger) == 1) ATT_WAITBAR(3); else ATT_WAITBAR(0); } } while (0)
    LAS float* wsf = (LAS float*)(lds + L_WS) + wid * 64;
    LAS float* tab = (LAS float*)(lds + L_TAB);
    if (TYPE == ATT_B) { if (tid < 257) tab[tid] = relb[tid] * LOG2E; }
    ATT_DMA(t_lo); if (t_lo + 1 < t_hi) ATT_DMA(t_lo + 1); if (t_lo + 2 < t_hi) ATT_DMA(t_lo + 2);
    float mhat = NEG, lsum = 0.f; f32x16 o0 = {}, o1 = {};
#define ATT_QK(P0, P1, t, ref) do { const int s_ = (t) & (NSLOT - 1); \
        if (TYPE == ATT_C) { const LAS float* kb = (const LAS float*)(auxl + s_ * 256); \
            _Pragma("unroll") for (int g4 = 0; g4 < 4; ++g4) { const f32x4 a_ = *(const LAS f32x4*)(kb + 8 * g4 + 4 * hi), c_ = *(const LAS f32x4*)(kb + 32 + 8 * g4 + 4 * hi); \
                _Pragma("unroll") for (int j_ = 0; j_ < 4; ++j_) { P0[4 * g4 + j_] = a_[j_] - (ref); P1[4 * g4 + j_] = c_[j_] - (ref); } } \
        } else if (TYPE == ATT_B) { const int dc = cq - (t); \
            if (dc >= 3) { const float cb = tab[256] - (ref); _Pragma("unroll") for (int r = 0; r < 16; ++r) { P0[r] = cb; P1[r] = cb; } } \
            else { const int dq = 64 * dc + (qw0 & 63) + r32; \
                _Pragma("unroll") for (int r = 0; r < 16; ++r) { int d0_ = dq - crow(r, hi), d1_ = d0_ - 32; d0_ = d0_ > 128 ? 128 : d0_; d1_ = d1_ > 128 ? 128 : d1_; \
                    P0[r] = tab[d0_ + 128] - (ref); P1[r] = tab[d1_ + 128] - (ref); } } \
        } else { const u32x2 mq = *(const LAS u32x2*)(auxl + s_ * 256 + r32 * 8); const unsigned w0 = mq.x >> (4 * hi), w1 = mq.y >> (4 * hi); const float nref = -(ref), negv = NEG; \
            P0[0] = bitsel<0>(w0, nref, negv); P1[0] = bitsel<0>(w1, nref, negv); P0[1] = bitsel<1>(w0, nref, negv); P1[1] = bitsel<1>(w1, nref, negv); P0[2] = bitsel<2>(w0, nref, negv); P1[2] = bitsel<2>(w1, nref, negv); P0[3] = bitsel<3>(w0, nref, negv); P1[3] = bitsel<3>(w1, nref, negv); P0[4] = bitsel<8>(w0, nref, negv); P1[4] = bitsel<8>(w1, nref, negv); P0[5] = bitsel<9>(w0, nref, negv); P1[5] = bitsel<9>(w1, nref, negv); P0[6] = bitsel<10>(w0, nref, negv); P1[6] = bitsel<10>(w1, nref, negv); P0[7] = bitsel<11>(w0, nref, negv); P1[7] = bitsel<11>(w1, nref, negv); P0[8] = bitsel<16>(w0, nref, negv); P1[8] = bitsel<16>(w1, nref, negv); P0[9] = bitsel<17>(w0, nref, negv); P1[9] = bitsel<17>(w1, nref, negv); P0[10] = bitsel<18>(w0, nref, negv); P1[10] = bitsel<18>(w1, nref, negv); P0[11] = bitsel<19>(w0, nref, negv); P1[11] = bitsel<19>(w1, nref, negv); P0[12] = bitsel<24>(w0, nref, negv); P1[12] = bitsel<24>(w1, nref, negv); P0[13] = bitsel<25>(w0, nref, negv); P1[13] = bitsel<25>(w1, nref, negv); P0[14] = bitsel<26>(w0, nref, negv); P1[14] = bitsel<26>(w1, nref, negv); P0[15] = bitsel<27>(w0, nref, negv); P1[15] = bitsel<27>(w1, nref, negv); } \
        if (!(DUMMY & 16)) { const LAS unsigned char* kb_ = lds + L_K + s_ * 8192 + hi * 1024 + r32 * 16; \
            _Pragma("unroll") for (int d0 = 0; d0 < 4; ++d0) { const bf16x8 k0 = *(const LAS bf16x8*)(kb_ + d0 * 2048), k1 = *(const LAS bf16x8*)(kb_ + d0 * 2048 + 512); \
                P0 = __builtin_amdgcn_mfma_f32_32x32x16_bf16(k0, qf[d0], P0, 0, 0, 0); P1 = __builtin_amdgcn_mfma_f32_32x32x16_bf16(k1, qf[d0], P1, 0, 0, 0); } } \
        if (TYPE == ATT_C) { if (64 * (t) + 63 > qw0) { const int qq = qw0 + r32 - 64 * (t); \
            _Pragma("unroll") for (int r = 0; r < 16; ++r) { const int kk = crow(r, hi); if (kk > qq) P0[r] = NEG; if (kk + 32 > qq) P1[r] = NEG; } } } \
    } while (0)
    f32x16 pc0, pc1, pn0, pn1; float refc = 0.f, refn = 0.f;
    ATT_SYNC(t_hi - 1 - t_lo);
    if (a_lo == t_lo) { refc = 0.f; ATT_QK(pc0, pc1, t_lo, refc); }
#define ATT_STEP(t, C0, C1, RC, N0, N1, RN) do { \
          \
        if ((t) + 1 < t_hi) { if ((t) + 2 < t_hi) ATT_SYNC(1); else ATT_SYNC(0); if ((t) + 3 < t_hi) ATT_DMA((t) + 3); } \
        const bool act = ((t) >= a_lo) && ((t) <= a_hi), actn = ((t) + 1 >= a_lo) && ((t) + 1 <= a_hi) && ((t) + 1 < t_hi); \
        if (actn) { RN = mhat < -1.0e29f ? 0.f : mhat; ATT_QK(N0, N1, (t) + 1, RN); } \
        if (act) { \
            const int s = (t) & (NSLOT - 1); \
            if (!(DUMMY & 2)) { \
            float ra = max3f(C0[0], C0[1], C1[0]), rb = max3f(C0[2], C0[3], C1[1]); ra = max3f(ra, C1[2], C1[3]); \
            _Pragma("unroll") for (int r = 4; r < 16; r += 4) { ra = max3f(ra, C0[r], C0[r + 1]); rb = max3f(rb, C0[r + 2], C0[r + 3]); ra = max3f(ra, C1[r], C1[r + 1]); rb = max3f(rb, C1[r + 2], C1[r + 3]); } \
            float rm = fmaxf(ra, rb); \
            { const u32x2 rr = __builtin_amdgcn_permlane32_swap(__float_as_uint(rm), __float_as_uint(rm), false, false); rm = fmaxf(__uint_as_float(rr[0]), __uint_as_float(rr[1])); } \
            const float mnew = fmaxf(mhat, rm + RC); \
            if (__any(mnew != RC)) {                   \
                const float f = __builtin_amdgcn_exp2f(mhat - mnew), dl = RC - mnew; \
                lsum *= f; \
                _Pragma("unroll") for (int r = 0; r < 16; ++r) { C0[r] += dl; C1[r] += dl; } \
                if (hi == 0) wsf[r32] = f; \
                LDS_WAIT(); \
                _Pragma("unroll") for (int g4 = 0; g4 < 4; ++g4) { const f32x4 fv = *(const LAS f32x4*)(wsf + 8 * g4 + 4 * hi); \
                    _Pragma("unroll") for (int j = 0; j < 4; ++j) { o0[4 * g4 + j] *= fv[j]; o1[4 * g4 + j] *= fv[j]; } } \
            } \
            mhat = mnew; \
            float ps = 0.f; \
            _Pragma("unroll") for (int r = 0; r < 16; ++r) { C0[r] = __builtin_amdgcn_exp2f(C0[r]); C1[r] = __builtin_amdgcn_exp2f(C1[r]); ps += C0[r] + C1[r]; } \
            lsum += ps; \
            } \
            u32x4 pw[4]; \
            _Pragma("unroll") for (int j = 0; j < 4; ++j) { pw[0][j] = cvtpk(C0[2 * j], C0[2 * j + 1]); pw[1][j] = cvtpk(C0[8 + 2 * j], C0[9 + 2 * j]); pw[2][j] = cvtpk(C1[2 * j], C1[2 * j + 1]); pw[3][j] = cvtpk(C1[8 + 2 * j], C1[9 + 2 * j]); } \
            const LAS unsigned char* vp = lds + L_V + s * 8192 + ((lane >> 4) & 1) * 32 + (lane & 3) * 8 + (4 * hi + ((lane & 15) >> 2)) * 64; \
            if (DUMMY & 16) { asm volatile("" :: "v"(pw[0]), "v"(pw[1]), "v"(pw[2]), "v"(pw[3])); } \
            else { \
            _Pragma("unroll") for (int ks = 0; ks < 4; ++ks) { \
                const s16x4 a0 = vtr(vp + ks * 1024), a1 = vtr(vp + ks * 1024 + 512), c0 = vtr(vp + 4096 + ks * 1024), c1 = vtr(vp + 4096 + ks * 1024 + 512); \
                const bf16x8 v0 = (bf16x8){a0[0], a0[1], a0[2], a0[3], a1[0], a1[1], a1[2], a1[3]}, v1 = (bf16x8){c0[0], c0[1], c0[2], c0[3], c1[0], c1[1], c1[2], c1[3]}; \
                const bf16x8 pa = __builtin_bit_cast(bf16x8, pw[ks]); \
                o0 = __builtin_amdgcn_mfma_f32_32x32x16_bf16(pa, v0, o0, 0, 0, 0); \
                o1 = __builtin_amdgcn_mfma_f32_32x32x16_bf16(pa, v1, o1, 0, 0, 0); \
            } } \
        } \
    } while (0)
    for (int t = t_lo; t < t_hi; t += 2) {
        ATT_STEP(t, pc0, pc1, refc, pn0, pn1, refn);
        ATT_STEP(t + 1, pn0, pn1, refn, pc0, pc1, refc);
    }
#undef ATT_STEP
    { const u32x2 rr = __builtin_amdgcn_permlane32_swap(__float_as_uint(lsum), __float_as_uint(lsum), false, false); lsum = __uint_as_float(rr[0]) + __uint_as_float(rr[1]); }
    if (hi == 0) wsf[32 + r32] = lsum;
    LDS_WAIT();
    LAS bf16_t* stg = (LAS bf16_t*)(lds + L_OST) + wid * 2048;
#pragma unroll
    for (int g4 = 0; g4 < 4; ++g4) { const f32x4 lv = *(const LAS f32x4*)(wsf + 32 + 8 * g4 + 4 * hi);
#pragma unroll
        for (int j = 0; j < 4; ++j) { const int r = 4 * g4 + j, orow = crow(r, hi); const float rl = __builtin_amdgcn_rcpf(lv[j]);
            stg[orow * 64 + r32] = (bf16_t)f2bf(o0[r] * rl); stg[orow * 64 + 32 + r32] = (bf16_t)f2bf(o1[r] * rl); } }
    LDS_WAIT();
    bf16_t* Ow = Op + (rowbase + qw0) * MIXW;
    if (DUMMY) { const u32x4 v = *(const LAS u32x4*)(stg + (lane >> 3) * 64 + (lane & 7) * 8); asm volatile("" :: "v"(v)); }
    else
#pragma unroll
    for (int i = 0; i < 4; ++i) { const int row = i * 8 + (lane >> 3), ch = lane & 7; const u32x4 v = *(const LAS u32x4*)(stg + row * 64 + ch * 8); *(u32x4*)(Ow + (size_t)row * MIXW + ch * 8) = v; }
    if (TYPE != ATT_A) { if (h == 4) {
        bf16_t* Oz = Op + (rowbase + qw0) * MIXW + 64;
#pragma unroll
        for (int i = 0; i < 4; ++i) { const int row = i * 8 + (lane >> 3), ch = lane & 7; *(u32x4*)(Oz + (size_t)row * MIXW + ch * 8) = (u32x4){0u, 0u, 0u, 0u}; } } }
    VM_WAIT(); __syncthreads();
#undef ATT_DMA
#undef ATT_SYNC
#undef ATT_QK
}
}

namespace att2 {
constexpr int NSLOT = 3, SLOTB = 8192;
constexpr int L_K = 0, L_V = NSLOT * SLOTB, L_AUX = 2 * NSLOT * SLOTB, L_WS = L_AUX + 8 * 768, L_OST = L_WS + 8 * 256, L_END = L_OST + 8 * 4096;
static_assert(L_END <= RING_BYTES, "attention LDS");
enum { T_A = 0, T_C = 2 };
#define SBAR() __builtin_amdgcn_sched_barrier(0)
#define WAIT_BAR(N) asm volatile("s_waitcnt vmcnt(" #N ") lgkmcnt(0)\n\ts_barrier" ::: "memory")
__device__ __forceinline__ void glds16(const void* gsrc, unsigned lds_dst) { unsigned keep;
    asm volatile("s_mov_b32 %0, m0\n\ts_mov_b32 m0, %2\n\ts_nop 0\n\tglobal_load_lds_dwordx4 %1, off\n\ts_mov_b32 m0, %0" : "=&s"(keep) : "v"(gsrc), "s"(lds_dst) : "memory"); }
__device__ __forceinline__ void glds4(const void* gsrc, unsigned lds_dst) { unsigned keep;
    asm volatile("s_mov_b32 %0, m0\n\ts_mov_b32 m0, %2\n\ts_nop 0\n\tglobal_load_lds_dword %1, off\n\ts_mov_b32 m0, %0" : "=&s"(keep) : "v"(gsrc), "s"(lds_dst) : "memory"); }
__device__ __forceinline__ void kload8(bf16x8* kf, const LAS unsigned char* kp) {
    kf[0] = *(const LAS bf16x8*)(kp);        kf[1] = *(const LAS bf16x8*)(kp + 512);  kf[2] = *(const LAS bf16x8*)(kp + 2048); kf[3] = *(const LAS bf16x8*)(kp + 2560);
    kf[4] = *(const LAS bf16x8*)(kp + 4096); kf[5] = *(const LAS bf16x8*)(kp + 4608); kf[6] = *(const LAS bf16x8*)(kp + 6144); kf[7] = *(const LAS bf16x8*)(kp + 6656); }
__device__ __forceinline__ void kload2(bf16x8* kf, const LAS unsigned char* kp, int j) { kf[2 * j] = *(const LAS bf16x8*)(kp + j * 2048); kf[2 * j + 1] = *(const LAS bf16x8*)(kp + j * 2048 + 512); }
__device__ __forceinline__ void cmask(f32x16& p0, f32x16& p1, int jb, int qrel, int hi) {
    const float NEG = -__builtin_inff(); const int kb = 64 * jb + 4 * hi;
#pragma unroll
    for (int r = 0; r < 16; ++r) { const int kv = kb + (r & 3) + 8 * (r >> 2); if (kv > qrel) p0[r] = NEG; if (kv + 32 > qrel) p1[r] = NEG; }
}
__device__ __forceinline__ void pv(f32x16* o, int vb, bf16x8 pa0, bf16x8 pa1, bf16x8 pa2, bf16x8 pa3) {
#pragma unroll
    for (int d0 = 0; d0 < 2; ++d0) { s16x4 lo[4], hi[4];
#pragma unroll
        for (int ks = 0; ks < 4; ++ks) {
            asm volatile("ds_read_b64_tr_b16 %0,%1 offset:%c2" : "=&v"(lo[ks]) : "v"(vb), "i"(d0 * 4096 + ks * 1024) : "memory");
            asm volatile("ds_read_b64_tr_b16 %0,%1 offset:%c2" : "=&v"(hi[ks]) : "v"(vb), "i"(d0 * 4096 + ks * 1024 + 512) : "memory"); }
        asm volatile("s_waitcnt lgkmcnt(0)" ::: "memory"); SBAR();
#define PK(k) (bf16x8){lo[k][0], lo[k][1], lo[k][2], lo[k][3], hi[k][0], hi[k][1], hi[k][2], hi[k][3]}
        o[d0] = __builtin_amdgcn_mfma_f32_32x32x16_bf16(pa0, PK(0), o[d0], 0, 0, 0);
        o[d0] = __builtin_amdgcn_mfma_f32_32x32x16_bf16(pa1, PK(1), o[d0], 0, 0, 0);
        o[d0] = __builtin_amdgcn_mfma_f32_32x32x16_bf16(pa2, PK(2), o[d0], 0, 0, 0);
        o[d0] = __builtin_amdgcn_mfma_f32_32x32x16_bf16(pa3, PK(3), o[d0], 0, 0, 0);
#undef PK
    }
}

template <int TYPE, int LD, int THRL>
__device__ __forceinline__ void attn_unit(LAS unsigned char* lds, const bf16_t* __restrict__ Qp, const bf16_t* __restrict__ Kp, const bf16_t* __restrict__ Vp, bf16_t* Op, int b, int h, int qb,
                                          const unsigned* aux, const float* relb, int tid_) {
    const int tid = launder_v(tid_), lane = tid & 63, r32 = lane & 31, hi = lane >> 5;
    const int wid = __builtin_amdgcn_readfirstlane(tid >> 6);
    const size_t rowbase = (size_t)b * SEQ; const int q0 = qb * 256;
    int t_lo = 0; const int t_hi = 4 * (qb + 1);
    if (TYPE == T_C) {
        const float* fn = (const float*)aux + (size_t)(b * 5 + h) * SEQ; const float lim = fn[q0] - 2.0f * relb[0] - 43.0f;
        const bool c0 = (lane < t_hi) && (fn[64 * lane + 63] < lim), c1 = (lane + 64 < t_hi) && (fn[64 * (lane + 64) + 63] < lim);
        t_lo = ((int)__builtin_popcountll(__ballot(c0)) + (int)__builtin_popcountll(__ballot(c1))) & ~1;
        if (t_lo > t_hi - 4) t_lo = t_hi - 4; }
    t_lo = __builtin_amdgcn_readfirstlane(t_lo);
    const int NT = t_hi - t_lo;
    const bf16_t* Qw = Qp + (rowbase + q0 + wid * 32) * LD + h * 64;
    const bf16_t* Kh = Kp + (rowbase + (size_t)t_lo * 64) * LD + h * 64, *Vh = Vp + (rowbase + (size_t)t_lo * 64) * LD + h * 64;
    const unsigned lds0 = (unsigned)(size_t)lds;
    LAS float* wsf = (LAS float*)(lds + L_WS) + wid * 64;
    const bf16_t* ksrc = Kh + (size_t)lane * LD + wid * 8;
    const bf16_t* vsrc = Vh + (size_t)(16 * (wid & 3) + (lane >> 2)) * LD + (wid >> 2) * 32 + (lane & 3) * 8;
    const unsigned* asrc = (TYPE == T_C) ? aux + (size_t)(b * 5 + h) * SEQ + (size_t)t_lo * 64 + lane : aux + ((size_t)(b * 256 + qb * 8 + wid) * 128) * 64 + lane;
    const unsigned kdst = lds0 + L_K + wid * 1024, vdst = lds0 + L_V + wid * 1024, adst = lds0 + L_AUX + wid * 768;
#define DMA_K(t, slot) glds16(ksrc + (size_t)(t) * 64 * LD, (unsigned)__builtin_amdgcn_readfirstlane(kdst + (slot)))
#define DMA_V(t, slot) glds16(vsrc + (size_t)(t) * 64 * LD, (unsigned)__builtin_amdgcn_readfirstlane(vdst + (slot)))
#define DMA_A(t, slot) glds4(asrc + (size_t)(t) * 64, (unsigned)__builtin_amdgcn_readfirstlane(adst + ((slot) >> 5)))
    const int vb0 = (int)(lds0 + L_V) + ((lane >> 4) & 1) * 32 + (lane & 3) * 8 + (4 * hi + ((lane & 15) >> 2)) * 64;
    bf16x8 kf[8];
    const LAS unsigned char* kp0 = lds + L_K + hi * 1024 + r32 * 16;
    const LAS unsigned char* vp0 = lds + L_V + ((lane >> 4) & 1) * 32 + (lane & 3) * 8 + (4 * hi + ((lane & 15) >> 2)) * 64;
    const LAS unsigned char* auxw = lds + L_AUX + wid * 768;
    DMA_K(0, 0); DMA_A(0, 0); DMA_A(1, SLOTB); DMA_A(2, 2 * SLOTB); DMA_V(0, 0); DMA_K(1, SLOTB);
    bf16x8 qr[4];
#pragma unroll
    for (int d0 = 0; d0 < 4; ++d0) qr[d0] = *(const bf16x8*)(Qw + (size_t)r32 * LD + d0 * 16 + hi * 8);
    float mhat = -1024.f, l_reg = 0.f; f32x16 o[2]; o[0] = f32x16{}; o[1] = f32x16{};
    const int qrel = wid * 32 + r32;
    const float NINF = -__builtin_inff();
    bool resc = false;
#define CMASK(P0, P1, t) do { if (TYPE == T_C) { const int jb_ = (t) - (NT - 4); if (jb_ >= 0) cmask(P0, P1, jb_, qrel, hi); } } while (0)
#define RESC() do { if (resc) { asm volatile("s_waitcnt lgkmcnt(0)" ::: "memory"); \
        _Pragma("unroll") for (int d_ = 0; d_ < 2; ++d_) _Pragma("unroll") for (int r = 0; r < 16; ++r) o[d_][r] *= wsf[crow(r, hi)]; } } while (0)
#define MX3(a, b, c) __builtin_fmaxf(__builtin_fmaxf((a), (b)), (c))
#define DECIDE(C0, C1) do { float ma_ = MX3(C0[0], C0[1], C1[0]), mb_ = MX3(C0[2], C0[3], C1[1]); ma_ = MX3(ma_, C1[2], C1[3]); \
        _Pragma("unroll") for (int r = 4; r < 16; r += 4) { ma_ = MX3(ma_, C0[r], C0[r + 1]); mb_ = MX3(mb_, C0[r + 2], C0[r + 3]); ma_ = MX3(ma_, C1[r], C1[r + 1]); mb_ = MX3(mb_, C1[r + 2], C1[r + 3]); } \
        float rm_ = __builtin_fmaxf(ma_, mb_); { const u32x2 rr_ = __builtin_amdgcn_permlane32_swap(__float_as_uint(rm_), __float_as_uint(rm_), false, false); rm_ = __builtin_fmaxf(__uint_as_float(rr_[0]), __uint_as_float(rr_[1])); } \
        resc = false; \
        if (__builtin_expect(__any(rm_ > (float)THRL), 0)) { const float dl_ = __builtin_fmaxf(rm_, 0.f); mhat += dl_; \
            _Pragma("unroll") for (int r = 0; r < 16; ++r) { C0[r] -= dl_; C1[r] -= dl_; } \
            const float f_ = __builtin_amdgcn_exp2f(-dl_); l_reg *= f_; if (hi == 0) wsf[r32] = f_; resc = true; } } while (0)
#define BSEL4(P, i, w) do { P[4 * (i)] = att::bitsel<8 * (i)>(w, nref_, NINF); P[4 * (i) + 1] = att::bitsel<8 * (i) + 1>(w, nref_, NINF); P[4 * (i) + 2] = att::bitsel<8 * (i) + 2>(w, nref_, NINF); P[4 * (i) + 3] = att::bitsel<8 * (i) + 3>(w, nref_, NINF); } while (0)
#define BRD(P0, P1, AO, i) do { if (TYPE == T_C) { const f32x4 v_ = *(const LAS f32x4*)(auxw + (AO) + ((i) < 4 ? 0 : 128) + 32 * ((i) & 3) + 16 * hi); \
        if ((i) < 4) { P0[4 * ((i) & 3)] = v_[0]; P0[4 * ((i) & 3) + 1] = v_[1]; P0[4 * ((i) & 3) + 2] = v_[2]; P0[4 * ((i) & 3) + 3] = v_[3]; } \
        else { P1[4 * ((i) & 3)] = v_[0]; P1[4 * ((i) & 3) + 1] = v_[1]; P1[4 * ((i) & 3) + 2] = v_[2]; P1[4 * ((i) & 3) + 3] = v_[3]; } } } while (0)
#define BPC(P0, P1, i) do { if (TYPE == T_C) { \
            if ((i) < 4) { P0[4 * ((i) & 3)] -= mhat; P0[4 * ((i) & 3) + 1] -= mhat; P0[4 * ((i) & 3) + 2] -= mhat; P0[4 * ((i) & 3) + 3] -= mhat; } \
            else { P1[4 * ((i) & 3)] -= mhat; P1[4 * ((i) & 3) + 1] -= mhat; P1[4 * ((i) & 3) + 2] -= mhat; P1[4 * ((i) & 3) + 3] -= mhat; } } \
        else { if ((i) < 4) BSEL4(P0, (i) & 3, wn0); else BSEL4(P1, (i) & 3, wn1); } } while (0)
#define MASKW(AO) do { if (TYPE == T_A) { const u32x2 mq_ = *(const LAS u32x2*)(auxw + (AO) + r32 * 8); wn0 = mq_.x >> (4 * hi); wn1 = mq_.y >> (4 * hi); } } while (0)
#define BLD_ALL(P0, P1, AO) do { unsigned wn0 = 0, wn1 = 0; const float nref_ = -mhat; (void)nref_; MASKW(AO); \
        BRD(P0, P1, AO, 0); BRD(P0, P1, AO, 1); BRD(P0, P1, AO, 2); BRD(P0, P1, AO, 3); BRD(P0, P1, AO, 4); BRD(P0, P1, AO, 5); BRD(P0, P1, AO, 6); BRD(P0, P1, AO, 7); \
        BPC(P0, P1, 0); BPC(P0, P1, 1); BPC(P0, P1, 2); BPC(P0, P1, 3); BPC(P0, P1, 4); BPC(P0, P1, 5); BPC(P0, P1, 6); BPC(P0, P1, 7); } while (0)
    f32x16 pA0, pA1, pB0, pB1;
    int sl_prev = 0, sl_cur = 0, sl_next = SLOTB;
#define ROT() do { sl_prev = sl_cur; sl_cur = sl_next; sl_next = (sl_next == (NSLOT - 1) * SLOTB) ? 0 : sl_next + SLOTB; } while (0)
    DMA_K(2, 2 * SLOTB);
    WAIT_BAR(3);
    BLD_ALL(pA0, pA1, 0);
    { const LAS unsigned char* kb_ = lds + L_K + hi * 1024 + r32 * 16;
#pragma unroll
      for (int d0 = 0; d0 < 4; ++d0) { const bf16x8 b0 = *(const LAS bf16x8*)(kb_ + d0 * 2048), b1 = *(const LAS bf16x8*)(kb_ + d0 * 2048 + 512);
          pA0 = __builtin_amdgcn_mfma_f32_32x32x16_bf16(b0, qr[d0], pA0, 0, 0, 0); pA1 = __builtin_amdgcn_mfma_f32_32x32x16_bf16(b1, qr[d0], pA1, 0, 0, 0); } }
    asm volatile("s_nop 15\n\ts_nop 7" : "+v"(pA0), "+v"(pA1));
    CMASK(pA0, pA1, 0);
    DECIDE(pA0, pA1);
#pragma unroll
    for (int r = 0; r < 16; ++r) { pA0[r] = __builtin_amdgcn_exp2f(pA0[r]); pA1[r] = __builtin_amdgcn_exp2f(pA1[r]); }
    BLD_ALL(pB0, pB1, SLOTB >> 5);
    WAIT_BAR(0);
    DMA_K(3, 0); DMA_A(3, 0); DMA_V(1, SLOTB);
    ROT();
    kload8(kf, kp0 + sl_cur);
    WAIT_BAR(3);
    s16x4 vlo[8], vhi[8]; u32x4 pw0, pw1, pw2, pw3;
#define PKW(P, B) cvtpk(P[B], P[B + 1])
#define PAF(k) __builtin_bit_cast(bf16x8, pw##k)
#define VFR(i) (bf16x8){vlo[i][0], vlo[i][1], vlo[i][2], vlo[i][3], vhi[i][0], vhi[i][1], vhi[i][2], vhi[i][3]}
#define PIN(x) asm volatile("" : "+v"(x))
#define GAPA(MF, A0, A1, A2, A3, W0, W1, PW) do { MF; sacc += A0; sacc += A1; sacc += A2; sacc += A3; PIN(sacc); W0; W1; PIN(PW); SBAR(); } while (0)
#define EX(v) __builtin_amdgcn_exp2f(v)
#define GAPB(MF, X, B, EXTRA) do { MF; X[B] = EX(X[B]); X[B + 1] = EX(X[B + 1]); X[B + 2] = EX(X[B + 2]); X[B + 3] = EX(X[B + 3]); PIN(X); EXTRA; SBAR(); } while (0)
#define VRD(i) do { vlo[i] = att::vtr(vp_ + (((i) >> 2) * 4096 + ((i) & 3) * 1024)); vhi[i] = att::vtr(vp_ + (((i) >> 2) * 4096 + ((i) & 3) * 1024 + 512)); } while (0)
#define KRD(G, j) do { if (G) { kload2(kf, kp0 + sl_next, j); SBAR(); } } while (0)
#define MFMA __builtin_amdgcn_mfma_f32_32x32x16_bf16
#define STEP(C0, C1, P0, P1, t, GK, GV, GL) do { SBAR(); \
        const LAS unsigned char* vp_ = vp0 + sl_prev; \
        unsigned wn0 = 0, wn1 = 0; if (GL) MASKW(sl_next >> 5); \
        VRD(0); SBAR(); float sacc = (P0[0] + P0[1]); \
        GAPA(C0 = MFMA(kf[0], qr[0], C0, 0, 0, 0), P0[2], P0[3], P0[4], P0[5],     pw0[0] = PKW(P0, 0), pw0[1] = PKW(P0, 2), pw0); \
        VRD(4); SBAR(); GAPA(C1 = MFMA(kf[1], qr[0], C1, 0, 0, 0), P0[6], P0[7], P0[8], P0[9],     pw0[2] = PKW(P0, 4), pw0[3] = PKW(P0, 6), pw0); \
        VRD(1); SBAR(); GAPA(C0 = MFMA(kf[2], qr[1], C0, 0, 0, 0), P0[10], P0[11], P0[12], P0[13], pw1[0] = PKW(P0, 8), pw1[1] = PKW(P0, 10), pw1); \
        VRD(5); SBAR(); GAPA(C1 = MFMA(kf[3], qr[1], C1, 0, 0, 0), P0[14], P0[15], P1[0], P1[1],   pw1[2] = PKW(P0, 12), pw1[3] = PKW(P0, 14), pw1); \
        VRD(2); SBAR(); GAPA(C0 = MFMA(kf[4], qr[2], C0, 0, 0, 0), P1[2], P1[3], P1[4], P1[5],     pw2[0] = PKW(P1, 0), pw2[1] = PKW(P1, 2), pw2); \
        VRD(6); SBAR(); GAPA(C1 = MFMA(kf[5], qr[2], C1, 0, 0, 0), P1[6], P1[7], P1[8], P1[9],     pw2[2] = PKW(P1, 4), pw2[3] = PKW(P1, 6), pw2); \
        VRD(3); SBAR(); GAPA(C0 = MFMA(kf[6], qr[3], C0, 0, 0, 0), P1[10], P1[11], P1[12], P1[13], pw3[0] = PKW(P1, 8), pw3[1] = PKW(P1, 10), pw3); \
        VRD(7); SBAR(); GAPA(C1 = MFMA(kf[7], qr[3], C1, 0, 0, 0), P1[14], P1[15], 0.f, 0.f,       pw3[2] = PKW(P1, 12), pw3[3] = PKW(P1, 14), pw3); \
        l_reg += sacc; \
        if (GK) { DMA_K((t) + 3, sl_cur); DMA_A((t) + 3, sl_cur); } if (GV) { DMA_V((t) + 1, sl_next); } \
        CMASK(C0, C1, t); \
        DECIDE(C0, C1); \
        const float nref_ = -mhat; (void)nref_; \
        SBAR(); \
        GAPB(o[0] = MFMA(PAF(0), VFR(0), o[0], 0, 0, 0), C0, 0, if (GL) { BRD(P0, P1, sl_next >> 5, 0); BRD(P0, P1, sl_next >> 5, 1); BRD(P0, P1, sl_next >> 5, 2); BRD(P0, P1, sl_next >> 5, 3); if (TYPE == T_A) { BPC(P0, P1, 0); PIN(P0); } }); \
        GAPB(o[1] = MFMA(PAF(0), VFR(4), o[1], 0, 0, 0), C0, 4, if (GL) { BRD(P0, P1, sl_next >> 5, 4); BRD(P0, P1, sl_next >> 5, 5); BRD(P0, P1, sl_next >> 5, 6); BRD(P0, P1, sl_next >> 5, 7); if (TYPE == T_A) { BPC(P0, P1, 1); PIN(P0); } else { BPC(P0, P1, 0); PIN(P0); } }); \
        KRD(GL, 0); GAPB(o[0] = MFMA(PAF(1), VFR(1), o[0], 0, 0, 0), C0, 8,  if (GL) { if (TYPE == T_A) { BPC(P0, P1, 2); } else { BPC(P0, P1, 1); } PIN(P0); }); \
        KRD(GL, 1); GAPB(o[1] = MFMA(PAF(1), VFR(5), o[1], 0, 0, 0), C0, 12, if (GL) { if (TYPE == T_A) { BPC(P0, P1, 3); } else { BPC(P0, P1, 2); } PIN(P0); }); \
        KRD(GL, 2); GAPB(o[0] = MFMA(PAF(2), VFR(2), o[0], 0, 0, 0), C1, 0,  if (GL) { if (TYPE == T_A) { BPC(P0, P1, 4); PIN(P1); } else { BPC(P0, P1, 3); PIN(P0); } }); \
        KRD(GL, 3); GAPB(o[1] = MFMA(PAF(2), VFR(6), o[1], 0, 0, 0), C1, 4,  if (GL) { if (TYPE == T_A) { BPC(P0, P1, 5); } else { BPC(P0, P1, 4); } PIN(P1); }); \
        GAPB(o[0] = MFMA(PAF(3), VFR(3), o[0], 0, 0, 0), C1, 8,  if (GL) { if (TYPE == T_A) { BPC(P0, P1, 6); } else { BPC(P0, P1, 5); } PIN(P1); }); \
        GAPB(o[1] = MFMA(PAF(3), VFR(7), o[1], 0, 0, 0), C1, 12, if (GL) { if (TYPE == T_A) { BPC(P0, P1, 7); } else { BPC(P0, P1, 6); BPC(P0, P1, 7); } PIN(P1); }); \
    } while (0)
    int t = 1;
#undef CMASK
#define CMASK(P0, P1, t) do { } while (0)
    for (; t + 5 < NT; t += 2) {
        STEP(pB0, pB1, pA0, pA1, t, true, true, true);       WAIT_BAR(3); RESC(); ROT();
        STEP(pA0, pA1, pB0, pB1, t + 1, true, true, true);   WAIT_BAR(3); RESC(); ROT();
    }
#undef CMASK
#define CMASK(P0, P1, t) do { if (TYPE == T_C) { const int jb_ = (t) - (NT - 4); if (jb_ >= 0) cmask(P0, P1, jb_, qrel, hi); } } while (0)
#define ENDW(tt) do { if ((tt) + 3 < NT) { WAIT_BAR(3); } else if ((tt) + 2 < NT) { WAIT_BAR(1); } else { WAIT_BAR(0); } } while (0)
    for (; t + 1 < NT; t += 2) {
        STEP(pB0, pB1, pA0, pA1, t, (t + 3 < NT), (t + 1 < NT), (t + 1 < NT));       ENDW(t);     RESC(); ROT();
        STEP(pA0, pA1, pB0, pB1, t + 1, (t + 4 < NT), (t + 2 < NT), (t + 2 < NT));   ENDW(t + 1); RESC(); ROT();
    }
    STEP(pB0, pB1, pA0, pA1, NT - 1, false, false, false); RESC();
    { float sacc = pB0[0] + pB0[1];
#pragma unroll
      for (int r = 2; r < 16; ++r) sacc += pB0[r];
#pragma unroll
      for (int r = 0; r < 16; ++r) sacc += pB1[r];
      l_reg += sacc;
      pw0 = (u32x4){PKW(pB0, 0), PKW(pB0, 2), PKW(pB0, 4), PKW(pB0, 6)}; pw1 = (u32x4){PKW(pB0, 8), PKW(pB0, 10), PKW(pB0, 12), PKW(pB0, 14)};
      pw2 = (u32x4){PKW(pB1, 0), PKW(pB1, 2), PKW(pB1, 4), PKW(pB1, 6)}; pw3 = (u32x4){PKW(pB1, 8), PKW(pB1, 10), PKW(pB1, 12), PKW(pB1, 14)};
      SBAR(); pv(o, vb0 + sl_cur, PAF(0), PAF(1), PAF(2), PAF(3)); }
#undef PKW
#undef PAF
#undef VFR
#undef PIN
#undef GAPA
#undef GAPB
#undef EX
#undef VRD
#undef KRD
#undef STEP
#undef ENDW
#undef MFMA
    { const u32x2 rr = __builtin_amdgcn_permlane32_swap(__float_as_uint(l_reg), __float_as_uint(l_reg), false, false); l_reg = __uint_as_float(rr[0]) + __uint_as_float(rr[1]); }
    if (hi == 0) wsf[32 + r32] = l_reg;
    asm volatile("s_waitcnt lgkmcnt(0)" ::: "memory");
    LAS bf16_t* stg = (LAS bf16_t*)(lds + L_OST) + wid * 2048;
#pragma unroll
    for (int g4 = 0; g4 < 4; ++g4) { const f32x4 lv = *(const LAS f32x4*)(wsf + 32 + 8 * g4 + 4 * hi);
#pragma unroll
        for (int j = 0; j < 4; ++j) { const int r = 4 * g4 + j, orow = crow(r, hi); const float rl = __builtin_amdgcn_rcpf(lv[j]);
            stg[orow * 64 + r32] = (bf16_t)f2bf(o[0][r] * rl); stg[orow * 64 + 32 + r32] = (bf16_t)f2bf(o[1][r] * rl); } }
    asm volatile("s_waitcnt lgkmcnt(0)" ::: "memory");
    bf16_t* Ow = Op + (rowbase + q0 + wid * 32) * MIXW;
#pragma unroll
    for (int i = 0; i < 4; ++i) { const int row = i * 8 + (lane >> 3), ch = lane & 7; const u32x4 v = *(const LAS u32x4*)(stg + row * 64 + ch * 8); *(u32x4*)(Ow + (size_t)row * MIXW + ch * 8) = v; }
    if (TYPE != T_A) { if (h == 4) {
        bf16_t* Oz = Ow + 64;
#pragma unroll
        for (int i = 0; i < 4; ++i) { const int row = i * 8 + (lane >> 3), ch = lane & 7; *(u32x4*)(Oz + (size_t)row * MIXW + ch * 8) = (u32x4){0u, 0u, 0u, 0u}; } } }
    asm volatile("s_waitcnt lgkmcnt(0)\n\ts_barrier" ::: "memory");
#undef DMA_K
#undef DMA_V
#undef DMA_A
#undef CMASK
#undef RESC
#undef ROT
#undef MX3
#undef DECIDE
#undef BSEL4
#undef BRD
#undef BPC
#undef MASKW
#undef BLD_ALL
}
#undef SBAR
#undef WAIT_BAR
}

__device__ __forceinline__ void scan_unit(Frame& F, int bh) {
    const int b = bh / 5, h = bh % 5;
    const float* FC = (const float*)(F.ws + WS_FC); float* FCUM = (float*)(F.ws + WS_FCUM) + (size_t)bh * SEQ;
    LAS float* wt = (LAS float*)F.lds;
    const int t0 = F.tid * 16;
    float v[16]; float run = 0.f;
#pragma unroll
    for (int j = 0; j < 16; ++j) { run += FC[((size_t)b * SEQ + t0 + j) * 8 + h]; v[j] = run; }
    float inc = run;
#pragma unroll
    for (int o = 1; o < 64; o <<= 1) { const float y = lane_get_f(inc, (F.lane - o) & 63); if (F.lane >= o) inc += y; }
    if (F.lane == 63) wt[F.wave] = inc;
    __syncthreads();
    float base = inc - run;
    for (int w = 0; w < F.wave; ++w) base += wt[w];
#pragma unroll
    for (int j = 0; j < 16; ++j) FCUM[t0 + j] = -(base + v[j]) * LOG2E;
    const bf16_t* QC = (const bf16_t*)(F.ws + P_QC) + ((size_t)b * SEQ + t0) * 320 + h * 64; const bf16_t* KC = (const bf16_t*)(F.ws + P_KC) + ((size_t)b * SEQ + t0) * 320 + h * 64;
    float mq = 0.f, mk = 0.f;
    for (int j = 0; j < 16; ++j) { float sq = 0.f, sk = 0.f;
#pragma unroll
        for (int c8 = 0; c8 < 8; ++c8) { const u32x4 a = *(const u32x4*)(QC + (size_t)j * 320 + c8 * 8), k4 = *(const u32x4*)(KC + (size_t)j * 320 + c8 * 8);
#pragma unroll
            for (int e = 0; e < 4; ++e) { const float a0 = bf2f(a[e] & 0xffff), a1 = bf2f(a[e] >> 16), k0 = bf2f(k4[e] & 0xffff), k1 = bf2f(k4[e] >> 16); sq = fmaf(a0, a0, fmaf(a1, a1, sq)); sk = fmaf(k0, k0, fmaf(k1, k1, sk)); } }
        mq = fmaxf(mq, sq); mk = fmaxf(mk, sk); }
#pragma unroll
    for (int o = 1; o < 64; o <<= 1) { mq = fmaxf(mq, lane_get_f(mq, F.lane ^ o)); mk = fmaxf(mk, lane_get_f(mk, F.lane ^ o)); }
    if (F.lane == 0) { wt[16 + F.wave] = mq; wt[32 + F.wave] = mk; }
    __syncthreads();
    if (F.tid == 0) { float a = 0.f, c = 0.f; for (int w = 0; w < 8; ++w) { a = fmaxf(a, wt[16 + w]); c = fmaxf(c, wt[32 + w]); }
        ((float*)(F.ws + WS_SMAX))[bh] = sqrtf(a * c) * 1.01f; }
    __syncthreads();
}

namespace idx {
constexpr int L_HIST = 0, L_MASK = 32768, L_LVAL = 65536, L_LKEY = 73728, L_LCNT = 81920, L_ST = 82048, L_PAR = 82304, L_BQ = 82560, L_NEED = 82688, L_RES = 82816, L_FLAG = 82944, L_QF = 98304, L_END = L_QF + 32768;
static_assert(L_END <= RING_BYTES, "index LDS");
constexpr int LCAP = 64, MAXLEV = 8;

__device__ __forceinline__ void load_kf(bf16x8 (&kf)[4], const bf16_t* __restrict__ kr) {
#pragma unroll
    for (int ks = 0; ks < 4; ++ks) kf[ks] = *(const bf16x8*)(kr + ks * 16);
}
#define IDX_LDQ(dst, h) do { _Pragma("unroll") for (int ks_ = 0; ks_ < 4; ++ks_) dst[ks_] = *(const LAS bf16x8*)(qfl + ((h) * 4 + ks_) * 1024); } while (0)
#define IDX_MM(d, q) do { _Pragma("unroll") for (int ks_ = 0; ks_ < 4; ++ks_) d = __builtin_amdgcn_mfma_f32_32x32x16_bf16(kf[ks_], q[ks_], ks_ ? d : zero16, 0, 0, 0); } while (0)
#define IDX_ACC(d, wh) do { _Pragma("unroll") for (int r_ = 0; r_ < 16; ++r_) sc[r_] = fmaf(fabsf(d[r_]), wh, sc[r_]); } while (0)
__device__ __forceinline__ f32x16 score_tile(const bf16x8 (&kf)[4], const LAS unsigned char* qfl_, const bf16x8 (&ql)[4], const float (&w)[8]) {
    const LAS unsigned char* qfl = qfl_; asm volatile("" : "+v"(qfl));
    const f32x16 zero16 = {};
    bf16x8 qa[4], qb[4], qc[4]; f32x16 sc, da, db;
    IDX_LDQ(qa, 0); IDX_LDQ(qb, 1);
    IDX_MM(sc, ql);
    IDX_LDQ(qc, 2); IDX_MM(da, qa);
    IDX_LDQ(qa, 3); IDX_MM(db, qb); IDX_ACC(da, w[0]);
    IDX_LDQ(qb, 4); IDX_MM(da, qc); IDX_ACC(db, w[1]);
    IDX_LDQ(qc, 5); IDX_MM(db, qa); IDX_ACC(da, w[2]);
    IDX_LDQ(qa, 6); IDX_MM(da, qb); IDX_ACC(db, w[3]);
    IDX_LDQ(qb, 7); IDX_MM(db, qc); IDX_ACC(da, w[4]);
    IDX_MM(da, qa); IDX_ACC(db, w[5]);
    IDX_MM(db, qb); IDX_ACC(da, w[6]);
    IDX_ACC(db, w[7]);
    return sc;
}
__device__ __forceinline__ int bucket(float s, float scale, float off) { return (int)fminf(fmaxf(fmaf(s, scale, off), 0.f), 255.f); }

__device__ __forceinline__ void index_slow(LAS unsigned char* lds, const LAS unsigned char* qfl, const bf16x8 (&ql)[4], const float (&w)[8], const bf16_t* __restrict__ kbase, unsigned* mg,
                                           int nk32, int ntot, int tid, int lane, int r32, int hi, int wid) {
    LAS unsigned* HIST = (LAS unsigned*)(lds + L_HIST); LAS unsigned* MASK = (LAS unsigned*)(lds + L_MASK);
    LAS float* LVAL = (LAS float*)(lds + L_LVAL); LAS unsigned* LKEY = (LAS unsigned*)(lds + L_LKEY); LAS unsigned* LCNT = (LAS unsigned*)(lds + L_LCNT);
    LAS float* ST = (LAS float*)(lds + L_ST); LAS float* PAR = (LAS float*)(lds + L_PAR); LAS int* BQ = (LAS int*)(lds + L_BQ); LAS int* NEED = (LAS int*)(lds + L_NEED);
    LAS int* RES = (LAS int*)(lds + L_RES); LAS unsigned* FLAG = (LAS unsigned*)(lds + L_FLAG);
    if (tid < 64) ST[tid] = 0.f;
    if (tid < 32) RES[tid] = 0;
    if (tid == 0) FLAG[0] = 0u;
    __syncthreads();
    const int stride = (nk32 / 16) > 1 ? (nk32 / 16) : 1, ns = (nk32 + stride - 1) / stride;
    { float s1 = 0.f, s2 = 0.f;
      bf16x8 kf[4]; load_kf(kf, kbase + (size_t)((wid < ns ? wid : 0) * stride) * 32 * 64);
      for (int j = wid; j < ns; j += 8) { bf16x8 kn[4]; load_kf(kn, kbase + (size_t)((j + 8 < ns ? j + 8 : j) * stride) * 32 * 64);
          const f32x16 sc = score_tile(kf, qfl, ql, w);
#pragma unroll
          for (int ks = 0; ks < 4; ++ks) kf[ks] = kn[ks];
#pragma unroll
          for (int r = 0; r < 16; ++r) { s1 += sc[r]; s2 = fmaf(sc[r], sc[r], s2); } }
      __hip_atomic_fetch_add(ST + 2 * r32, s1, __ATOMIC_RELAXED, __HIP_MEMORY_SCOPE_WORKGROUP);
      __hip_atomic_fetch_add(ST + 2 * r32 + 1, s2, __ATOMIC_RELAXED, __HIP_MEMORY_SCOPE_WORKGROUP); }
    __syncthreads();
    if (tid < 32) { const float n = (float)(ns * 32), mean = ST[2 * tid] / n; float var = ST[2 * tid + 1] / n - mean * mean; var = var > 1e-20f ? var : 1e-20f;
        const float sd = sqrtf(var), lo = mean - 3.5f * sd; PAR[2 * tid] = lo; PAR[2 * tid + 1] = 254.0f / (10.0f * sd); }
    __syncthreads();
    for (int lev = 0; lev < MAXLEV; ++lev) {
        for (int i = tid; i < 2048; i += 512) ((LAS u32x4*)HIST)[i] = (u32x4){0u, 0u, 0u, 0u};
        __syncthreads();
        { const float scale = PAR[2 * r32 + 1], off = fmaf(-PAR[2 * r32], scale, 1.0f); const bool act = RES[r32] == 0;
          bf16x8 kf[4]; load_kf(kf, kbase + (size_t)wid * 32 * 64);
          for (int kt = wid; kt < nk32; kt += 8) { bf16x8 kn[4]; load_kf(kn, kbase + (size_t)(kt + 8 < nk32 ? kt + 8 : kt) * 32 * 64);
              const f32x16 sc = score_tile(kf, qfl, ql, w);
#pragma unroll
              for (int ks = 0; ks < 4; ++ks) kf[ks] = kn[ks];
              if (act) {
#pragma unroll
                  for (int r = 0; r < 16; ++r) __hip_atomic_fetch_add(HIST + r32 * 256 + bucket(sc[r], scale, off), 1u, __ATOMIC_RELAXED, __HIP_MEMORY_SCOPE_WORKGROUP); } } }
        __syncthreads();
        for (int qq = 0; qq < 4; ++qq) { const int q = wid * 4 + qq;
            if (RES[q] == 0) {
                const u32x4 hv = *(const LAS u32x4*)(HIST + q * 256 + 4 * lane);
                const unsigned sl = hv.x + hv.y + hv.z + hv.w; unsigned suf = sl;
#pragma nounroll
                for (int o = 1; o < 64; o <<= 1) { const unsigned y = lane_get_u(suf, (lane + o) & 63); if (lane + o < 64) suf += y; }
                const unsigned ge3 = suf - sl + hv.w, ge2 = ge3 + hv.z, ge1 = ge2 + hv.y, ge0 = ge1 + hv.x, above = suf - sl;
                int bq = -1; unsigned ab = 0, pop = 0;
                if (above < 256u && ge0 >= 256u) {
                    if (ge3 >= 256u) { bq = 4 * lane + 3; ab = above; pop = hv.w; }
                    else if (ge2 >= 256u) { bq = 4 * lane + 2; ab = ge3; pop = hv.z; }
                    else if (ge1 >= 256u) { bq = 4 * lane + 1; ab = ge2; pop = hv.y; }
                    else { bq = 4 * lane; ab = ge1; pop = hv.x; }
                    BQ[q] = bq; NEED[q] = 256 - (int)ab;
                    const float lo = PAR[2 * q], scale = PAR[2 * q + 1];
                    if (bq >= 1 && bq <= 254 && pop <= (unsigned)LCAP) RES[q] = 1;
                    else { if (bq == 255) { PAR[2 * q] = lo + 254.0f / scale; PAR[2 * q + 1] = scale * 0.0625f; }
                           else if (bq == 0) { PAR[2 * q + 1] = scale * 0.0625f; PAR[2 * q] = lo - 254.0f / (scale * 0.0625f); }
                           else { PAR[2 * q] = lo + (float)(bq - 1) / scale; PAR[2 * q + 1] = scale * 254.0f; }
                           __hip_atomic_fetch_add(FLAG, 1u, __ATOMIC_RELAXED, __HIP_MEMORY_SCOPE_WORKGROUP); }
                }
            }
        }
        __syncthreads();
        const unsigned unresolved = FLAG[0];
        __syncthreads();
        if (tid == 0) FLAG[0] = 0u;
        if (unresolved == 0u) break;
    }
    if (tid < 32) LCNT[tid] = 0u;
    __syncthreads();
    { const float scale = PAR[2 * r32 + 1], off = fmaf(-PAR[2 * r32], scale, 1.0f); const int bq = BQ[r32]; const bool res = RES[r32] != 0;
      bf16x8 kf[4]; load_kf(kf, kbase + (size_t)wid * 32 * 64);
      for (int kt = wid; kt < nk32; kt += 8) { bf16x8 kn[4]; load_kf(kn, kbase + (size_t)(kt + 8 < nk32 ? kt + 8 : kt) * 32 * 64);
          const f32x16 sc = score_tile(kf, qfl, ql, w);
#pragma unroll
          for (int ks = 0; ks < 4; ++ks) kf[ks] = kn[ks];
          unsigned bits = 0u;
#pragma unroll
          for (int r = 0; r < 16; ++r) { const int bk = bucket(sc[r], scale, off);
              const bool sel = (bk > bq) || (!res && bk == bq);
              bits |= (sel ? 1u : 0u) << ((r & 3) + 8 * (r >> 2));
              if (res && bk == bq) { const unsigned pos = __hip_atomic_fetch_add(LCNT + r32, 1u, __ATOMIC_RELAXED, __HIP_MEMORY_SCOPE_WORKGROUP);
                  if (pos < (unsigned)LCAP) { LVAL[r32 * LCAP + pos] = sc[r]; LKEY[r32 * LCAP + pos] = (unsigned)(kt * 32 + crow(r, hi)); } } }
          bits <<= 4 * hi;
          { const u32x2 rr = __builtin_amdgcn_permlane32_swap(bits, bits, false, false); bits = rr[0] | rr[1]; }
          if (hi == 0) MASK[kt * 32 + r32] = bits; } }
    __syncthreads();
    for (int qq = 0; qq < 4; ++qq) { const int q = wid * 4 + qq;
        if (RES[q] != 0) { const int n = (int)(LCNT[q] < (unsigned)LCAP ? LCNT[q] : (unsigned)LCAP), need = NEED[q];
            const float v = lane < n ? LVAL[q * LCAP + lane] : 0.f; const unsigned k = lane < n ? LKEY[q * LCAP + lane] : 0u;
            int rank = 0;
            for (int j = 0; j < n; ++j) { const float vj = LVAL[q * LCAP + j]; const unsigned kj = LKEY[q * LCAP + j]; rank += ((vj > v) || (vj == v && kj < k)) ? 1 : 0; }
            if (lane < n && rank < need) __hip_atomic_fetch_or(MASK + (k >> 5) * 32 + q, 1u << (k & 31), __ATOMIC_RELAXED, __HIP_MEMORY_SCOPE_WORKGROUP); } }
    __syncthreads();
    for (int i = tid; i < ntot * 32; i += 512) { const int t32 = 2 * (i >> 6) + (i & 1), q = (i >> 1) & 31; mg[i] = (t32 < nk32) ? MASK[t32 * 32 + q] : 0u; }
    __syncthreads();
}
__device__ __forceinline__ int hist_cross(const LAS unsigned* hrow, unsigned target, int lane, unsigned* above, unsigned* pop) {
    const u32x4 hv = *(const LAS u32x4*)(hrow + 4 * lane);
    const unsigned sl = hv.x + hv.y + hv.z + hv.w; unsigned suf = sl;
#pragma nounroll
    for (int o = 1; o < 64; o <<= 1) { const unsigned y = lane_get_u(suf, (lane + o) & 63); if (lane + o < 64) suf += y; }
    const unsigned ab = suf - sl, ge3 = ab + hv.w, ge2 = ge3 + hv.z, ge1 = ge2 + hv.y, ge0 = ge1 + hv.x;
    int bq = -1; unsigned a_ = 0, p_ = 0;
    if (ab < target && ge0 >= target) {
        if (ge3 >= target) { bq = 4 * lane + 3; a_ = ab; p_ = hv.w; }
        else if (ge2 >= target) { bq = 4 * lane + 2; a_ = ge3; p_ = hv.z; }
        else if (ge1 >= target) { bq = 4 * lane + 1; a_ = ge2; p_ = hv.y; }
        else { bq = 4 * lane; a_ = ge1; p_ = hv.x; }
    }
    const u64 m = __ballot(bq >= 0);
    if (m == 0ull) { *above = 0; *pop = 0; return -1; }
    const int src = (int)__builtin_ctzll(m);
    *above = lane_get_u(a_, src); *pop = lane_get_u(p_, src);
    return (int)lane_get_u((unsigned)bq, src);
}

constexpr int FCAP = 512, LF_VAL = 0, LF_KEY = 65536, LF_HIST = 0  ;
constexpr int LS_ST = RING_BYTES + 4096, LS_TW = LS_ST + 256, LS_CNT = LS_TW + 384, LS_LCNT = LS_CNT + 128, LS_FAIL = LS_LCNT + 128, LS_WH = RING_BYTES + 6144  ,
              LS_CV = LS_WH + 8192  , LS_END = LS_CV + 8 * 512;
static_assert(LF_KEY + 32 * FCAP * 2 <= L_QF && LS_END <= LDS_BYTES && L_END <= RING_BYTES, "index LDS");

__device__ __forceinline__ void index_unit(LAS unsigned char* lds, const bf16_t* __restrict__ QI, const bf16_t* __restrict__ KI, const float* __restrict__ WI, u64* maskT, int b, int qt, int tid_) {
    const int tid = launder_v(tid_), lane = tid & 63, r32 = lane & 31, hi = lane >> 5;
    const int wid = __builtin_amdgcn_readfirstlane(tid >> 6);
    const int c = qt >> 1, nk32 = 2 * (c + 1), ntot = 8 * ((qt >> 3) + 1);
    unsigned* mg = (unsigned*)(maskT + ((size_t)(b * 256 + qt) * 128) * 32);
    if (c <= 3) { for (int i = tid; i < ntot * 32; i += 512) { const int t32 = 2 * (i >> 6) + (i & 1); mg[i] = (t32 < nk32) ? 0xFFFFFFFFu : 0u; } return; }
    const size_t qrow = (size_t)b * SEQ + qt * 32 + r32;
    bf16x8 ql[4]; float w[8];
    { const f32x4 w0 = *(const f32x4*)(WI + qrow * 8), w1 = *(const f32x4*)(WI + qrow * 8 + 4);
      w[0] = w0[0]; w[1] = w0[1]; w[2] = w0[2]; w[3] = w0[3]; w[4] = w1[0]; w[5] = w1[1]; w[6] = w1[2]; w[7] = w1[3]; }
    const LAS unsigned char* qfl = lds + L_QF + hi * 512 + r32 * 16;
#pragma unroll
    for (int ks = 0; ks < 4; ++ks) *(LAS bf16x8*)(lds + L_QF + (wid * 4 + ks) * 1024 + hi * 512 + r32 * 16) = *(const bf16x8*)(QI + qrow * 512 + wid * 64 + ks * 16 + hi * 8);
    __syncthreads();
#pragma unroll
    for (int ks = 0; ks < 4; ++ks) { float a[8];
#pragma unroll
        for (int j = 0; j < 8; ++j) a[j] = 0.f;
#pragma unroll
        for (int h = 0; h < 8; ++h) { const bf16x8 qv = *(const LAS bf16x8*)(qfl + (h * 4 + ks) * 1024);
#pragma unroll
            for (int j = 0; j < 8; ++j) a[j] = fmaf(w[h], bf2f((unsigned short)qv[j]), a[j]); }
        u32x4 pk; pk.x = pk2(a[0], a[1]); pk.y = pk2(a[2], a[3]); pk.z = pk2(a[4], a[5]); pk.w = pk2(a[6], a[7]);
        ql[ks] = __builtin_bit_cast(bf16x8, pk); __builtin_amdgcn_sched_barrier(0); }
    const bf16_t* kbase = KI + ((size_t)b * SEQ + r32) * 64 + hi * 8;
    LAS float* ST = (LAS float*)(lds + LS_ST); LAS float* TW = (LAS float*)(lds + LS_TW);
    LAS unsigned* CNT = (LAS unsigned*)(lds + LS_CNT); LAS unsigned* LCNT = (LAS unsigned*)(lds + LS_LCNT); LAS unsigned* FAIL = (LAS unsigned*)(lds + LS_FAIL);
    LAS float* FVAL = (LAS float*)(lds + LF_VAL); LAS unsigned short* FKEY = (LAS unsigned short*)(lds + LF_KEY); LAS unsigned* SH = (LAS unsigned*)(lds + LF_HIST);
    if (tid < 64) ST[tid] = 0.f;
    if (tid < 32) { CNT[tid] = 0u; LCNT[tid] = 0u; }
    if (tid == 0) FAIL[0] = 0u;
    for (int i = tid; i < 2048; i += 512) ((LAS u32x4*)SH)[i] = (u32x4){0u, 0u, 0u, 0u};
    __syncthreads();
    { bf16x8 kf[4]; load_kf(kf, kbase + (size_t)((wid * nk32) >> 3) * 2048);
      const f32x16 sc = score_tile(kf, qfl, ql, w); float s1 = 0.f, s2 = 0.f;
#pragma unroll
      for (int r = 0; r < 16; ++r) { s1 += sc[r]; s2 = fmaf(sc[r], sc[r], s2); }
      __hip_atomic_fetch_add(ST + 2 * r32, s1, __ATOMIC_RELAXED, __HIP_MEMORY_SCOPE_WORKGROUP);
      __hip_atomic_fetch_add(ST + 2 * r32 + 1, s2, __ATOMIC_RELAXED, __HIP_MEMORY_SCOPE_WORKGROUP); }
    __syncthreads();
    const int ns = nk32 <= 64 ? nk32 : (nk32 >> 2);
    { const float mean = ST[2 * r32] * (1.0f / 256.0f); float var = ST[2 * r32 + 1] * (1.0f / 256.0f) - mean * mean; var = var > 1e-20f ? var : 1e-20f;
      const float sd = sqrtf(var), lo = mean - 4.0f * sd, scale = 254.0f / (11.0f * sd), off = fmaf(-lo, scale, 1.0f);
      if (wid == 0 && hi == 0) { TW[3 * r32] = lo; TW[3 * r32 + 2] = scale; }
      bf16x8 kf[4]; load_kf(kf, kbase + (size_t)(((wid < ns ? wid : 0) * nk32) / ns) * 2048);
      for (int j = wid; j < ns; j += 8) { bf16x8 kn[4]; load_kf(kn, kbase + (size_t)(((j + 8 < ns ? j + 8 : j) * nk32) / ns) * 2048);
          const f32x16 sc = score_tile(kf, qfl, ql, w);
#pragma unroll
          for (int ks = 0; ks < 4; ++ks) kf[ks] = kn[ks];
#pragma unroll
          for (int r = 0; r < 16; ++r) __hip_atomic_fetch_add(SH + r32 * 256 + bucket(sc[r], scale, off), 1u, __ATOMIC_RELAXED, __HIP_MEMORY_SCOPE_WORKGROUP); } }
    __syncthreads();
    for (int qq = 0; qq < 4; ++qq) { const int q = wid * 4 + qq;
        const unsigned ks_ = (256u * (unsigned)ns + (unsigned)nk32 - 1u) / (unsigned)nk32;
        const unsigned mrg = ns < nk32 ? (unsigned)(4.5f * sqrtf((float)ks_) + 1.0f) : 0u;
        const unsigned t_lo = ks_ + mrg, t_hi = ks_ > mrg + 1u ? ks_ - mrg : 1u;
        unsigned ab, pop; const int b1 = hist_cross(SH + q * 256, t_lo, lane, &ab, &pop); const int b2 = hist_cross(SH + q * 256, t_hi, lane, &ab, &pop);
        if (lane == 0) { const float lo = TW[3 * q], scale = TW[3 * q + 2];
            const float Tlo = b1 >= 1 ? lo + (float)(b1 - 1) / scale : -3.0e38f, Thi = b2 >= 254 ? 3.0e38f : lo + (float)(b2 < 0 ? 0 : b2) / scale;
            TW[3 * q] = Tlo; TW[3 * q + 1] = Thi; } }
    __syncthreads();
    { const float Tlo = TW[3 * r32], Thi = TW[3 * r32 + 1]; unsigned chi = 0u;
      bf16x8 kf[4]; load_kf(kf, kbase + (size_t)wid * 2048);
      for (int kt = wid; kt < nk32; kt += 8) { bf16x8 kn[4]; load_kf(kn, kbase + (size_t)(kt + 8 < nk32 ? kt + 8 : kt) * 2048);
          const f32x16 sc = score_tile(kf, qfl, ql, w);
#pragma unroll
          for (int ks = 0; ks < 4; ++ks) kf[ks] = kn[ks];
          unsigned bits = 0u; unsigned posq[16]; bool inw[16];
          constexpr int PD = 7;
#pragma unroll
          for (int r = 0; r < 16 + PD; ++r) {
              if (r < 16) { const float sv = sc[r]; const bool top = sv >= Thi;
                  bits |= (top ? 1u : 0u) << ((r & 3) + 8 * (r >> 2)); chi += top ? 1u : 0u;
                  inw[r] = sv >= Tlo && !top; posq[r] = 0u;
                  if (inw[r]) posq[r] = __hip_atomic_fetch_add(LCNT + r32, 1u, __ATOMIC_RELAXED, __HIP_MEMORY_SCOPE_WORKGROUP); }
              if (r >= PD) { const int s = r - PD;
                  if (inw[s] && posq[s] < (unsigned)FCAP) { FVAL[r32 * FCAP + posq[s]] = sc[s]; FKEY[r32 * FCAP + posq[s]] = (unsigned short)(kt * 32 + crow(s, hi)); } } }
          bits <<= 4 * hi;
          { const u32x2 rr = __builtin_amdgcn_permlane32_swap(bits, bits, false, false); bits = rr[0] | rr[1]; }
          if (hi == 0) mg[((kt >> 1) * 32 + r32) * 2 + (kt & 1)] = bits; }
      __hip_atomic_fetch_add(CNT + r32, chi, __ATOMIC_RELAXED, __HIP_MEMORY_SCOPE_WORKGROUP); }
    for (int i = nk32 * 32 + tid; i < ntot * 32; i += 512) { const int t32 = i >> 5, q = i & 31; mg[((t32 >> 1) * 32 + q) * 2 + (t32 & 1)] = 0u; }
    VM_WAIT(); __syncthreads();
    if (tid < 32) { const unsigned chi = CNT[tid], n = LCNT[tid]; if (chi > 256u || 256u - chi > n || n > (unsigned)FCAP) FAIL[0] = 1u; }
    __syncthreads();
    if (FAIL[0] != 0u) { index_slow(lds, qfl, ql, w, kbase, mg, nk32, ntot, tid, lane, r32, hi, wid); return; }
    LAS unsigned* WH = (LAS unsigned*)(lds + LS_WH) + wid * 256; LAS float* CVv = (LAS float*)(lds + LS_CV + wid * 512); LAS unsigned* CVk = (LAS unsigned*)(lds + LS_CV + wid * 512 + 256);
    for (int qq = 0; qq < 4; ++qq) { const int q = wid * 4 + qq;
        const int n = (int)LCNT[q], need = 256 - (int)CNT[q];
        if (need <= 0) continue;
        const LAS float* fv = FVAL + q * FCAP; const LAS unsigned short* fk = FKEY + q * FCAP;
        if (need < n) {
            float lo = TW[3 * q], span = TW[3 * q + 1] - lo; lo = lo > -1.0e38f ? lo : 0.f; span = span < 1.0e37f && span > 0.f ? span : 1.0f;
            float scale = 254.0f / span; int bq = 0; unsigned ab = 0, pop = 0;
            for (int lev = 0; lev < 6; ++lev) {
                *(LAS u32x4*)(WH + 4 * lane) = (u32x4){0u, 0u, 0u, 0u};
                const float off = fmaf(-lo, scale, 1.0f);
#pragma nounroll
                for (int i = lane; i < n; i += 64) __hip_atomic_fetch_add(WH + bucket(fv[i], scale, off), 1u, __ATOMIC_RELAXED, __HIP_MEMORY_SCOPE_WORKGROUP);
                LDS_WAIT();
                bq = hist_cross(WH, (unsigned)need, lane, &ab, &pop);
                if (pop <= 64u || lev == 5) break;
                lo = lo + (float)(bq - 1) / scale; scale = scale * 254.0f;
            }
            const float off = fmaf(-lo, scale, 1.0f);
            if (lane == 0) WH[0] = 0u;
            LDS_WAIT();
#pragma nounroll
            for (int i = lane; i < n; i += 64) { const float vi = fv[i]; if (bucket(vi, scale, off) == bq) { const unsigned pos = __hip_atomic_fetch_add(WH, 1u, __ATOMIC_RELAXED, __HIP_MEMORY_SCOPE_WORKGROUP);
                if (pos < 64u) { CVv[pos] = vi; CVk[pos] = (unsigned)fk[i]; } } }
            LDS_WAIT();
            const int nc = (int)(WH[0] < 64u ? WH[0] : 64u), take = need - (int)ab;
#pragma nounroll
            for (int i = lane; i < n; i += 64) { const float vi = fv[i]; const unsigned ki = (unsigned)fk[i]; const int bk = bucket(vi, scale, off); bool in = bk > bq;
                if (bk == bq) { int rank = 0; for (int j = 0; j < nc; ++j) { const float vj = CVv[j]; const unsigned kj = CVk[j]; rank += ((vj > vi) || (vj == vi && kj < ki)) ? 1 : 0; } in = rank < take; }
                if (in) atomicOr(mg + ((ki >> 6) * 32 + q) * 2 + ((ki >> 5) & 1), 1u << (ki & 31)); }
        } else {
#pragma nounroll
            for (int i = lane; i < n; i += 64) { const unsigned ki = (unsigned)fk[i]; atomicOr(mg + ((ki >> 6) * 32 + q) * 2 + ((ki >> 5) & 1), 1u << (ki & 31)); }
        }
    }
    VM_WAIT(); __syncthreads();
}
#undef IDX_LDQ
#undef IDX_MM
#undef IDX_ACC
}

constexpr int ARGTAB_OFF = RING_BYTES + 128;
__device__ __forceinline__ unsigned char* argp(LAS unsigned char* lds, int k) {
    const u32x2 v = *(volatile LAS u32x2*)(lds + ARGTAB_OFF + 8 * k);
    const unsigned lo = __builtin_amdgcn_readfirstlane(v.x), hi = __builtin_amdgcn_readfirstlane(v.y);
    return (unsigned char*)(GAS unsigned char*)(((u64)hi << 32) | lo);
}
#define ARG_IN(k) ((const void*)argp(LDSB, (k)))
#define ARG_OUT ((float*)argp(LDSB, 15))
#define ARG_WS (argp(LDSB, 16))
__device__ __forceinline__ int q_ask(unsigned* ctr, int tid) { int v = 0; if (tid == 0) v = (int)__hip_atomic_fetch_add(ctr, 1u, RLX_AGENT); return v; }
__device__ __forceinline__ int q_take(LAS unsigned char* lds, int v, int tid) {
    volatile LAS int* slot = (volatile LAS int*)(lds + RING_BYTES + 64);
    __syncthreads();
    if (tid == 0) *slot = v;
    __syncthreads();
    return *slot;
}

constexpr int PH_PRO = 0, PH_PER_LAYER = 10, PH_FINAL = 1 + DEPTH * PH_PER_LAYER, NPHASE = PH_FINAL + 1;
#ifndef REP_X
#define REP_X 1
#endif
#ifndef REP_Y
#define REP_Y 1
#endif
#ifndef REP_P1
#define REP_P1 1
#endif
#ifndef REP_F1
#define REP_F1 1
#endif
#ifndef REP_Z
#define REP_Z 1
#endif
#ifndef REP_N
#define REP_N 1
#endif
#ifndef REP2_X
#define REP2_X 7
#endif
#ifndef REP2_Y
#define REP2_Y 3
#endif
#ifndef REP_PRO
#define REP_PRO 1
#endif
#ifndef REP_G
#define REP_G 1
#endif
#ifndef ATT_DUMMY
#define ATT_DUMMY 0
#endif
#ifndef MK_ONE_LAUNCH
#define MK_ONE_LAUNCH 1
#endif

__global__ void __launch_bounds__(512, 2) fwd_kernel(Args args) {
    extern __shared__ __attribute__((aligned(16))) unsigned char lds_raw[];
    LAS unsigned char* const LDSB = (LAS unsigned char*)lds_raw;
    {
        const int tid0 = threadIdx.x;
        for (int u = tid0; u < (LDS_BYTES - RING_BYTES) / 4; u += 512) ((LAS unsigned*)(LDSB + RING_BYTES))[u] = 0u;
        __syncthreads();
        if (tid0 < 15) *(LAS u64*)(LDSB + ARGTAB_OFF + 8 * tid0) = (u64)args.in[tid0];
        if (tid0 == 15) *(LAS u64*)(LDSB + ARGTAB_OFF + 8 * 15) = (u64)args.out;
        if (tid0 == 16) *(LAS u64*)(LDSB + ARGTAB_OFF + 8 * 16) = (u64)args.ws;
        __syncthreads();
    }
    const int wave0 = __builtin_amdgcn_readfirstlane((int)threadIdx.x >> 6);
    if (MK_ONE_LAUNCH) (void)xcd_barrier_post((unsigned*)(ARG_WS + WS_CTL) + CW_BAR, (volatile LAS unsigned*)(LDSB + MISC_OFF) + 8, tid_from_wave(wave0));
#define GRID_BARRIER() do { XcdBarrier bar_; bar_.bar = (unsigned*)(ARG_WS + WS_CTL) + CW_BAR; bar_.x = xb_xcc_id(); bar_.st = (volatile LAS unsigned*)(LDSB + MISC_OFF) + 8; xcd_barrier(bar_, tid_from_wave(wave0)); } while (0)
    const int lo = args.ph_lo, hi = args.ph_hi;
#ifndef DBG_MASK
#define DBG_MASK 0xFFFF
#endif
#define IN(k) (lo <= (k) && (k) < hi)
#define EN(j) ((DBG_MASK >> (j)) & 1)
#define SEAM(k) do { if (MK_ONE_LAUNCH && IN((k) + 1)) GRID_BARRIER(); } while (0)
#define PH_FRAME unsigned char* ws = ARG_WS; Frame Fp; Fp.lds = LDSB; Fp.ws = ws; Fp.ctl = (unsigned*)(ws + WS_CTL); Fp.tid = tid_from_wave(wave0); Fp.lane = Fp.tid & 63; \
        Fp.wave = __builtin_amdgcn_readfirstlane(Fp.tid >> 6); Fp.G = launder_i(gridDim.x); Fp.bid = launder_i(blockIdx.x)
#define PH_LOCALS PH_FRAME; unsigned char* wl = ws + WS_W + (size_t)l * W_LAYER; const float* modl = (const float*)(ws + WS_MOD) + (size_t)l * 4 * 6144; const int bidl = Fp.bid, Gl = Fp.G; \
        float* xres = ARG_OUT; const float* xcur = (l == 0) ? (const float*)ARG_IN(0) : (const float*)xres; (void)wl; (void)modl; (void)bidl; (void)Gl; (void)xcur
    if (EN(10) && IN(PH_PRO)) { PH_FRAME;
        const void* ain[15];
#pragma unroll
        for (int i = 0; i < 15; ++i) ain[i] = ARG_IN(i);
        for (int rep = 0; rep < REP_PRO; ++rep) { phase_prologue(Fp, ain); if (rep + 1 < REP_PRO) GRID_BARRIER(); }
        SEAM(PH_PRO); }

#define LAYER_BODY(LL) { const int l = (LL); \
        const int pb = 1 + l * PH_PER_LAYER; \
        if (l == 0 && EN(0) && IN(pb + 0)) { PH_LOCALS; phase_first(Fp, xcur, (const float*)ARG_IN(5), (const float*)(ws + WS_MOD), nullptr); SEAM(pb + 0); } \
        if (EN(1) && IN(pb + 1)) { PH_LOCALS; \
            pg8::Gemm g{(const bf16_t*)(ws + WS_H), (const bf16_t*)(wl + W_P1), MTOK, NP1, DM, DM, DM, 0, 0}; pg8::StaticOrder S; S.init(MTOK, NP1, Gl, bidl); \
            pg8::EpiProj E{ws, (const float*)(ws + WS_CB) + (size_t)l * 4 * NCB1, (const float*)(ws + WS_SS) + (size_t)(2 * l) * MTOK}; \
            for (int rep = 0; rep < REP_P1; ++rep) { pg8::gemm_phase<pg8::EpiProj>(Fp.lds, g, S, E, Fp.tid); if (rep + 1 < REP_P1) GRID_BARRIER(); } \
            SEAM(pb + 1); \
        } \
        if (EN(2) && IN(pb + 2)) { PH_LOCALS; \
            for (int rep = 0; rep < REP_X; ++rep) { \
            unsigned* ctr = (unsigned*)(ARG_WS + WS_CTL) + CW_Q + 64 * ((2 * l) * 4 + rep); \
            constexpr int N_SCAN = 20, N_IDX = 1024, N_B = 640; \
            const float* relb_l = (const float*)ARG_IN(8) + (size_t)l * 5 * 257; \
            for (int u = q_take(LDSB, q_ask(ctr, tid_from_wave(wave0)), tid_from_wave(wave0)); u < N_SCAN + N_IDX + N_B; ) { \
                unsigned char* ws = launder(Fp.ws); Frame Fu; Fu.lds = LDSB; Fu.ws = ws; Fu.ctl = (unsigned*)(ws + WS_CTL); Fu.tid = tid_from_wave(wave0); Fu.lane = Fu.tid & 63; Fu.wave = __builtin_amdgcn_readfirstlane(Fu.tid >> 6); Fu.G = 0; Fu.bid = 0; \
                const int xm = rep ? REP2_X : 7; \
                if (u < N_SCAN) { if (xm & 1) scan_unit(Fu, u); } \
                else if (u < N_SCAN + N_IDX) { if (xm & 2) { const int v = u - N_SCAN, qt = 255 - (v >> 2), b = v & 3; \
                    idx::index_unit(LDSB, (const bf16_t*)(ws + P_QI), (const bf16_t*)(ws + P_KI), (const float*)(ws + WS_WI), (u64*)(ws + WS_BM), b, qt, Fu.tid); } } \
                else if (xm & 4) { const int v = u - N_SCAN - N_IDX, qb = 31 - v / 20, rem = v % 20, b = rem / 5, h = rem % 5; \
                    att::attn_unit<att::ATT_B>(LDSB, (const bf16_t*)(ws + P_QB), (const bf16_t*)(ws + P_KB), (const bf16_t*)(ws + P_VB), 320, \
                        (bf16_t*)(ws + WS_MIX) + KBR + h * 64, b, h, qb, nullptr, relb_l + h * 257, Fu.tid); } \
                u = q_take(LDSB, q_ask(ctr, tid_from_wave(wave0)), tid_from_wave(wave0)); } \
            if (rep + 1 < REP_X) GRID_BARRIER(); } \
            SEAM(pb + 2); \
        } \
        if (EN(3) && IN(pb + 3)) { PH_LOCALS; \
            for (int rep = 0; rep < REP_Y; ++rep) { \
            unsigned* ctr = (unsigned*)(ARG_WS + WS_CTL) + CW_Q + 64 * ((2 * l + 1) * 4 + rep); \
            for (int u = q_take(LDSB, q_ask(ctr, tid_from_wave(wave0)), tid_from_wave(wave0)); u < 32 * 44; ) { \
                unsigned char* ws = launder(Fp.ws); const int tidu = tid_from_wave(wave0); \
                const int qb = 31 - u / 44, rem = u % 44; const int ym = rep ? REP2_Y : 3; \
                if (rem < 24) { if (ym & 1) { const int b = rem / 6, h = rem % 6; \
                    if (ATT_DUMMY && rep) att::attn_unit<att::ATT_A, ATT_DUMMY>(LDSB, (const bf16_t*)(ws + P_QA), (const bf16_t*)(ws + P_KA), (const bf16_t*)(ws + P_VA), 384, \
                        (bf16_t*)(ws + WS_MIX) + h * 64, b, h, qb, (const unsigned*)(ws + WS_BM), nullptr, tidu); \
                    else att2::attn_unit<att2::T_A, 384, 8>(LDSB, (const bf16_t*)(ws + P_QA), (const bf16_t*)(ws + P_KA), (const bf16_t*)(ws + P_VA), \
                        (bf16_t*)(ws + WS_MIX) + h * 64, b, h, qb, (const unsigned*)(ws + WS_BM), nullptr, tidu); } } \
                else if (ym & 2) { const int b = (rem - 24) / 5, h = (rem - 24) % 5; \
                    att2::attn_unit<att2::T_C, 320, 8>(LDSB, (const bf16_t*)(ws + P_QC), (const bf16_t*)(ws + P_KC), (const bf16_t*)(ws + P_VC), \
                        (bf16_t*)(ws + WS_MIX) + 2 * KBR + h * 64, b, h, qb, (const unsigned*)(ws + WS_FCUM), (const float*)(ws + WS_SMAX) + b * 5 + h, tidu); } \
                u = q_take(LDSB, q_ask(ctr, tid_from_wave(wave0)), tid_from_wave(wave0)); } \
            if (rep + 1 < REP_Y) GRID_BARRIER(); } \
            SEAM(pb + 3); \
        } \
        if (EN(4) && IN(pb + 4)) { PH_LOCALS; \
            pg8::Gemm g{(const bf16_t*)(ws + WS_MIX), (const bf16_t*)(wl + W_BR), MTOK, 3072, KBR, MIXW, KBR, 4, KBR * 2}; pg8::StaticOrder S; S.init(MTOK, 3072, Gl, bidl); \
            pg8::EpiPlain E{(bf16_t*)(ws + WS_P), 3072}; \
            for (int rep = 0; rep < REP_Z; ++rep) { pg8::gemm_phase<pg8::EpiPlain>(Fp.lds, g, S, E, Fp.tid); if (rep + 1 < REP_Z) GRID_BARRIER(); } \
            SEAM(pb + 4); \
        } \
        if (EN(5) && IN(pb + 5)) { PH_LOCALS; \
            pg8::Gemm g{(const bf16_t*)(ws + WS_H), (const bf16_t*)(wl + W_P2), MTOK, NP2, DM, DM, DM, 0, 0}; pg8::StaticOrder S; S.init(MTOK, NP2, Gl, bidl, 1); \
            pg8::EpiGate E{(const bf16_t*)(ws + WS_P), (bf16_t*)(ws + WS_Y), (const float*)(ws + WS_CB) + (size_t)l * 4 * NCB1 + NP1, (const float*)(ws + WS_SS) + (size_t)(2 * l) * MTOK}; \
            for (int rep = 0; rep < REP_G; ++rep) { pg8::gemm_phase<pg8::EpiGate>(Fp.lds, g, S, E, Fp.tid); if (rep + 1 < REP_G) GRID_BARRIER(); } \
            SEAM(pb + 5); \
        } \
        if (EN(6) && IN(pb + 6)) { PH_LOCALS; \
            pg8::Gemm g{(const bf16_t*)(ws + WS_Y), (const bf16_t*)(wl + W_OUT), MTOK, DM, DM, DM, DM, 0, 0}; pg8::StaticOrder S; S.init(MTOK, DM, Gl, bidl); \
            if (l == 0) { pg8::EpiRes<false, true> E{ARG_IN(0), (void*)xres, modl + 2048, (bf16_t*)(ws + WS_H), (const float*)ARG_IN(11) + l * DM, modl + 4096, (float*)(ws + WS_SS) + (size_t)(2 * l + 1) * MTOK}; \
                pg8::gemm_phase<pg8::EpiRes<false, true>>(Fp.lds, g, S, E, Fp.tid); } \
            else { pg8::EpiRes<true, true> E{(const void*)((const bf16_t*)xres + (size_t)MTOK * DM), (void*)(ws + WS_MIX), modl + 2048, (bf16_t*)(ws + WS_H), (const float*)ARG_IN(11) + l * DM, modl + 4096, (float*)(ws + WS_SS) + (size_t)(2 * l + 1) * MTOK}; \
                pg8::gemm_phase<pg8::EpiRes<true, true>>(Fp.lds, g, S, E, Fp.tid); } \
            SEAM(pb + 6); \
        } \
        if (EN(8) && IN(pb + 8)) { PH_LOCALS; \
            pg8::Gemm g{(const bf16_t*)(ws + WS_H), (const bf16_t*)(wl + W_F1), MTOK, 2 * FFH, DM, DM, DM, 0, 0}; pg8::StaticOrder S; S.init(MTOK, 2 * FFH, Gl, bidl); \
            pg8::EpiSwiGLU E{(bf16_t*)(ws + WS_P), (const float*)(ws + WS_CB) + CB2_OFF + (size_t)l * 4 * NCB2, (const float*)(ws + WS_SS) + (size_t)(2 * l + 1) * MTOK}; \
            for (int rep = 0; rep < REP_F1; ++rep) { pg8::gemm_phase<pg8::EpiSwiGLU>(Fp.lds, g, S, E, Fp.tid); if (rep + 1 < REP_F1) GRID_BARRIER(); } \
            SEAM(pb + 8); \
        } \
        if (EN(9) && IN(pb + 9)) { PH_LOCALS; \
            pg8::Gemm g{(const bf16_t*)(ws + WS_P), (const bf16_t*)(wl + W_F2), MTOK, DM, FFH, FFH, FFH, 0, 0}; pg8::StaticOrder S; S.init(MTOK, DM, Gl, bidl); \
            if (l + 1 < DEPTH) { pg8::EpiRes<true, true> E{(const void*)xres, (void*)((bf16_t*)xres + (size_t)MTOK * DM), modl + 5120, (bf16_t*)(ws + WS_H), (const float*)ARG_IN(5) + (l + 1 < DEPTH ? l + 1 : 0) * DM, \
                (const float*)(ws + WS_MOD) + (size_t)(l + 1 < DEPTH ? l + 1 : 0) * 4 * 6144 + 1024, (float*)(ws + WS_SS) + (size_t)(2 * (l + 1 < DEPTH ? l + 1 : 0)) * MTOK}; \
                pg8::gemm_phase<pg8::EpiRes<true, true>>(Fp.lds, g, S, E, Fp.tid); } \
            else { pg8::EpiRes<true, true> E{(const void*)(ws + WS_MIX), (void*)(ws + WS_Y), modl + 5120, (bf16_t*)nullptr, (const float*)ARG_IN(5), (const float*)(ws + WS_MOD) + 1024, (float*)(ws + WS_SSF)}; \
                pg8::gemm_phase<pg8::EpiRes<true, true>>(Fp.lds, g, S, E, Fp.tid); } \
            SEAM(pb + 9); \
        } \
    }
    LAYER_BODY(0)
    LAYER_BODY(1)
#undef LAYER_BODY
    if (EN(11) && IN(PH_FINAL)) { PH_FRAME; phase_final_norm(Fp, ARG_OUT, (const float*)ARG_IN(14)); }
#undef IN
#undef SEAM
}

extern "C" void kernel_launch(void* const* d_in, const int* in_sizes, int n_in, void* d_out, int out_size, void* d_ws, size_t ws_size, hipStream_t stream) {
    static int grid = 0;
    if (grid == 0) {
        if (n_in != 15 || out_size != MTOK * DM || ws_size < WS_END) { fprintf(stderr, "kernel_launch: unexpected problem (n_in %d out %d ws %zu)\n", n_in, out_size, ws_size); grid = -1; return; }
        int dev = 0, cus = 0, per_cu = 0;
        if (hipGetDevice(&dev) != hipSuccess || hipDeviceGetAttribute(&cus, hipDeviceAttributeMultiprocessorCount, dev) != hipSuccess) { grid = -1; return; }
        if (hipFuncSetAttribute((const void*)fwd_kernel, hipFuncAttributeMaxDynamicSharedMemorySize, LDS_BYTES) != hipSuccess) { fprintf(stderr, "kernel_launch: hipFuncSetAttribute failed\n"); grid = -1; return; }
        if (hipOccupancyMaxActiveBlocksPerMultiprocessor(&per_cu, (const void*)fwd_kernel, 512, LDS_BYTES) != hipSuccess || per_cu < 1) fprintf(stderr, "kernel_launch: occupancy query says %d\n", per_cu);
        (void)hipGetLastError();
        grid = cus;
    }
    if (grid < 0) return;
    (void)hipMemsetAsync((char*)d_ws + WS_CTL, 0, CTL_ZERO_BYTES, stream);
    Args a{};
    for (int i = 0; i < 15; ++i) a.in[i] = d_in[i];
    a.out = (float*)d_out; a.ws = (unsigned char*)d_ws;
#if MK_ONE_LAUNCH
    a.ph_lo = 0; a.ph_hi = NPHASE;
    hipLaunchKernelGGL(fwd_kernel, dim3(grid), dim3(512), LDS_BYTES, stream, a);
#else
    for (int p = 0; p < NPHASE; ++p) { a.ph_lo = p; a.ph_hi = p + 1; hipLaunchKernelGGL(fwd_kernel, dim3(grid), dim3(512), LDS_BYTES, stream, a); }
#endif
}
```
